# Optimizing an MI355X kernel written in HIP

```python
import math
import jax, jax.numpy as jnp
from jax import lax
import numpy as np

D_MODEL = 1024
BATCH = 4
SEQ = 8192
DEPTH = 4

GRID_W = 64
CTX_LEN = 256
N_MIXERS = 2
EPS = 1e-6

RET_HEADS = 4
RET_DK = 256
RET_DV = 512
RET_QK = RET_HEADS * RET_DK
RET_V = RET_HEADS * RET_DV
RET_IN = 2 * RET_QK + 2 * RET_V
RET_CHUNK = 128
ROPE_BASE = 10000.0

LRU_WIDTH = 1280
LRU_BLOCKS = 10
LRU_BW = LRU_WIDTH // LRU_BLOCKS
CONV_W = 4
LRU_C = 8.0

N_RET = (DEPTH + 1) // 2
N_LRU = DEPTH // 2

kernel_name = "hybrid_retention_rglru_prefix_dit"


def rms_norm(t, g):
    tf = t.astype(jnp.float32)
    y = tf * lax.rsqrt(jnp.mean(tf * tf, axis=-1, keepdims=True) + EPS)
    return (y * g.astype(jnp.float32)).astype(t.dtype)


def axial_rope_tables(n_tok):
    n_rows = n_tok // GRID_W
    row = jnp.repeat(jnp.arange(n_rows, dtype=jnp.float32), GRID_W)
    col = jnp.tile(jnp.arange(GRID_W, dtype=jnp.float32), n_rows)
    n_freq = RET_DK // 4
    inv = ROPE_BASE ** (-jnp.arange(n_freq, dtype=jnp.float32) / n_freq)
    ang = jnp.concatenate([row[:, None] * inv, col[:, None] * inv], axis=-1)
    return jnp.cos(ang), jnp.sin(ang)


def apply_rope(t, cos, sin):
    te, to = t[..., 0::2], t[..., 1::2]
    return jnp.stack([te * cos - to * sin, te * sin + to * cos], axis=-1).reshape(t.shape)


def split_heads(t, dh):
    b, n, _ = t.shape
    return t.reshape(b, n, -1, dh).transpose(0, 2, 1, 3).astype(jnp.float32)


def retention_scan(q, k, v, log_g, state0):
    b, h, n_tok, dk = q.shape
    dv = v.shape[-1]
    n_chunk = n_tok // RET_CHUNK
    idx = jnp.arange(RET_CHUNK, dtype=jnp.float32)
    rel = idx[:, None] - idx[None, :]
    intra = jnp.where(rel >= 0, jnp.exp(log_g[:, None, None] * jnp.maximum(rel, 0.0)), 0.0)
    q_dec = jnp.exp(log_g[:, None] * (idx + 1.0))[:, :, None]
    k_dec = jnp.exp(log_g[:, None] * (RET_CHUNK - 1.0 - idx))[:, :, None]
    chunk_dec = jnp.exp(log_g * RET_CHUNK)[:, None, None]

    def chunks(a):
        return jnp.moveaxis(a.reshape(b, h, n_chunk, RET_CHUNK, a.shape[-1]), 2, 0)

    def step(state, qkv):
        qc, kc, vc = qkv
        s = jnp.einsum('bhcd,bhsd->bhcs', qc, kc) * intra
        o = (jnp.einsum('bhcs,bhse->bhce', s, vc)
             + jnp.einsum('bhcd,bhde->bhce', qc * q_dec, state))
        state = state * chunk_dec + jnp.einsum('bhsd,bhse->bhde', kc * k_dec, vc)
        return state, o

    state, o = lax.scan(step, state0, (chunks(q), chunks(k), chunks(v)))
    o = jnp.moveaxis(o, 0, 2).reshape(b, h, n_tok, dv)
    return o, state


def retention_output(o, g, gn_g, w_out):
    mu = jnp.mean(o, axis=-1, keepdims=True)
    var = jnp.mean(jnp.square(o - mu), axis=-1, keepdims=True)
    o = (o - mu) * lax.rsqrt(var + EPS)
    b, h, n_tok, dv = o.shape
    o = o.transpose(0, 2, 1, 3).reshape(b, n_tok, h * dv) * gn_g.astype(jnp.float32)
    return (o * jax.nn.silu(g.astype(jnp.float32))).astype(w_out.dtype) @ w_out


def retention_mixer(h_lat, h_ctx, cos, sin, w_in, log_decay, gn_g, w_out, need_ctx):
    log_g = -jnp.abs(log_decay.astype(jnp.float32))
    scale = RET_DK ** -0.5

    def project(hh):
        p = hh @ w_in
        q = split_heads(p[..., :RET_QK], RET_DK)
        k = split_heads(p[..., RET_QK:2 * RET_QK], RET_DK) * scale
        v = split_heads(p[..., 2 * RET_QK:2 * RET_QK + RET_V], RET_DV)
        g = p[..., 2 * RET_QK + RET_V:]
        return q, k, v, g

    q_l, k_l, v_l, g_l = project(h_lat)
    q_l, k_l = apply_rope(q_l, cos, sin), apply_rope(k_l, cos, sin)
    q_c, k_c, v_c, g_c = project(h_ctx)

    b = h_lat.shape[0]
    zero = jnp.zeros((b, RET_HEADS, RET_DK, RET_DV), jnp.float32)
    flip = lambda a: jnp.flip(a, axis=2)
    oc_f, sc_f = retention_scan(q_c, k_c, v_c, log_g[0], zero)
    oc_b, sc_b = retention_scan(flip(q_c), flip(k_c), flip(v_c), log_g[1], zero)
    ol_f, _ = retention_scan(q_l, k_l, v_l, log_g[0], sc_f)
    ol_b, _ = retention_scan(flip(q_l), flip(k_l), flip(v_l), log_g[1], sc_b)
    y_lat = retention_output(ol_f + flip(ol_b), g_l, gn_g, w_out)
    y_ctx = retention_output(oc_f + flip(oc_b), g_c, gn_g, w_out) if need_ctx else None
    return y_lat, y_ctx


def conv_centred(t, w, bias):
    n_tok = t.shape[1]
    left = CONV_W // 2
    tp = jnp.pad(t, ((0, 0), (left, CONV_W - 1 - left), (0, 0)))
    out = bias.astype(jnp.float32)
    for j in range(CONV_W):
        out = out + tp[:, j:j + n_tok] * w[j].astype(jnp.float32)
    return out


def rglru_coeffs(xc, w_a, b_a, w_x, b_x, lam):
    b, n_tok, wd = xc.shape
    xb = xc.reshape(b, n_tok, LRU_BLOCKS, LRU_BW)
    r = jax.nn.sigmoid(jnp.einsum('btni,nij->btnj', xb, w_a.astype(jnp.float32)).reshape(b, n_tok, wd)
                       + b_a.astype(jnp.float32))
    gi = jax.nn.sigmoid(jnp.einsum('btni,nij->btnj', xb, w_x.astype(jnp.float32)).reshape(b, n_tok, wd)
                        + b_x.astype(jnp.float32))
    log_a = -LRU_C * r * jax.nn.softplus(-lam.astype(jnp.float32))
    a = jnp.exp(log_a)
    u = jnp.sqrt(-jnp.expm1(2.0 * log_a)) * gi * xc
    return a, u


def linear_scan(a, u, h0):
    def comb(e1, e2):
        a1, u1 = e1
        a2, u2 = e2
        return a1 * a2, a2 * u1 + u2
    a_cum, hs = lax.associative_scan(comb, (a, u), axis=1)
    return hs + a_cum * h0[:, None, :]


def lru_mixer(h_lat, h_ctx, w_in, conv_w, conv_b, w_a, b_a, w_x, b_x, lam, w_out, need_ctx):
    def branch(hh):
        p = hh @ w_in
        xr = p[..., :LRU_WIDTH].astype(jnp.float32)
        return conv_centred(xr, conv_w, conv_b), p[..., LRU_WIDTH:]

    xc_l, g_l = branch(h_lat)
    xc_c, g_c = branch(h_ctx)
    b = h_lat.shape[0]
    zero = jnp.zeros((b, LRU_WIDTH), jnp.float32)
    flip = lambda t: jnp.flip(t, axis=1)
    hl_sum = 0.0
    hc_sum = 0.0
    for d in range(2):
        a_c, u_c = rglru_coeffs(xc_c, w_a[d], b_a[d], w_x[d], b_x[d], lam[d])
        a_l, u_l = rglru_coeffs(xc_l, w_a[d], b_a[d], w_x[d], b_x[d], lam[d])
        if d == 1:
            a_c, u_c, a_l, u_l = flip(a_c), flip(u_c), flip(a_l), flip(u_l)
        hc = linear_scan(a_c, u_c, zero)
        hl = linear_scan(a_l, u_l, hc[:, -1])
        if d == 1:
            hc, hl = flip(hc), flip(hl)
        hl_sum = hl_sum + hl
        hc_sum = hc_sum + hc
    y_lat = (hl_sum * jax.nn.silu(g_l.astype(jnp.float32))).astype(w_out.dtype) @ w_out
    y_ctx = ((hc_sum * jax.nn.silu(g_c.astype(jnp.float32))).astype(w_out.dtype) @ w_out) if need_ctx else None
    return y_lat, y_ctx


def setup_inputs(seed: int = 0) -> dict:
    key = jax.random.key(seed)
    ks = jax.random.split(key, 24)
    f32 = jnp.float32
    nrm = lambda k, shape, s: jax.random.normal(k, shape, f32) * s
    x = nrm(ks[0], (BATCH, SEQ, D_MODEL), 1.0)
    c = nrm(ks[1], (BATCH, D_MODEL), 1.0)
    ctx = nrm(ks[2], (BATCH, CTX_LEN, D_MODEL), 1.0)
    c_ctx = nrm(ks[3], (D_MODEL,), 1.0)
    mod_w = nrm(ks[4], (DEPTH, D_MODEL, 3 * D_MODEL), D_MODEL ** -0.5)
    mod_b = nrm(ks[5], (DEPTH, 3 * D_MODEL), 0.02)
    norm_pre = 1.0 + nrm(ks[6], (DEPTH, D_MODEL), 0.02)
    norm_post = 1.0 + nrm(ks[7], (DEPTH, D_MODEL), 0.02)
    ret_w_in = nrm(ks[8], (N_RET, D_MODEL, RET_IN), D_MODEL ** -0.5)
    base = jnp.log1p(-(2.0 ** (-5.0 - jnp.arange(RET_HEADS, dtype=f32))))
    ret_log_decay = base * (1.0 + nrm(ks[9], (N_RET, 2, RET_HEADS), 0.1))
    ret_gn = 1.0 + nrm(ks[10], (N_RET, RET_V), 0.02)
    ret_w_out = nrm(ks[11], (N_RET, RET_V, D_MODEL), RET_V ** -0.5)
    lru_w_in = nrm(ks[12], (N_LRU, D_MODEL, 2 * LRU_WIDTH), D_MODEL ** -0.5)
    lru_conv_w = nrm(ks[13], (N_LRU, CONV_W, LRU_WIDTH), CONV_W ** -0.5)
    lru_conv_b = nrm(ks[14], (N_LRU, LRU_WIDTH), 0.01)
    lru_w_a = nrm(ks[15], (N_LRU, 2, LRU_BLOCKS, LRU_BW, LRU_BW), LRU_BW ** -0.5)
    lru_b_a = nrm(ks[16], (N_LRU, 2, LRU_WIDTH), 0.01)
    lru_w_x = nrm(ks[17], (N_LRU, 2, LRU_BLOCKS, LRU_BW, LRU_BW), LRU_BW ** -0.5)
    lru_b_x = nrm(ks[18], (N_LRU, 2, LRU_WIDTH), 0.01)
    a_pow_c = jax.random.uniform(ks[19], (N_LRU, 2, LRU_WIDTH), f32, 0.9, 0.999)
    a_base = a_pow_c ** (1.0 / LRU_C)
    lru_lambda = jnp.log(a_base) - jnp.log1p(-a_base)
    lru_w_out = nrm(ks[20], (N_LRU, LRU_WIDTH, D_MODEL), LRU_WIDTH ** -0.5)
    return {"x": x, "c": c, "ctx": ctx, "c_ctx": c_ctx,
            "mod_w": mod_w, "mod_b": mod_b, "norm_pre": norm_pre, "norm_post": norm_post,
            "ret_w_in": ret_w_in, "ret_log_decay": ret_log_decay, "ret_gn": ret_gn, "ret_w_out": ret_w_out,
            "lru_w_in": lru_w_in, "lru_conv_w": lru_conv_w, "lru_conv_b": lru_conv_b,
            "lru_w_a": lru_w_a, "lru_b_a": lru_b_a, "lru_w_x": lru_w_x, "lru_b_x": lru_b_x,
            "lru_lambda": lru_lambda, "lru_w_out": lru_w_out}


def reference(x, c, ctx, c_ctx, mod_w, mod_b, norm_pre, norm_post,
              ret_w_in, ret_log_decay, ret_gn, ret_w_out,
              lru_w_in, lru_conv_w, lru_conv_b, lru_w_a, lru_b_a, lru_w_x, lru_b_x,
              lru_lambda, lru_w_out):
    n_tok = x.shape[1]
    cos, sin = axial_rope_tables(n_tok)
    s_ctx = ctx
    act_l = jax.nn.silu(c)
    act_c = jax.nn.silu(c_ctx)
    for i in range(DEPTH):
        need_ctx = i < DEPTH - 1
        shift_l, scale_l, gate_l = jnp.split(act_l @ mod_w[i] + mod_b[i], 3, axis=-1)
        shift_c, scale_c, gate_c = jnp.split(act_c @ mod_w[i] + mod_b[i], 3, axis=-1)
        h_l = rms_norm(x, norm_pre[i]) * (1.0 + scale_l[:, None, :]) + shift_l[:, None, :]
        h_c = rms_norm(s_ctx, norm_pre[i]) * (1.0 + scale_c) + shift_c
        j = i // N_MIXERS
        if i % N_MIXERS == 0:
            y_l, y_c = retention_mixer(h_l, h_c, cos, sin, ret_w_in[j], ret_log_decay[j],
                                       ret_gn[j], ret_w_out[j], need_ctx)
        else:
            y_l, y_c = lru_mixer(h_l, h_c, lru_w_in[j], lru_conv_w[j], lru_conv_b[j],
                                 lru_w_a[j], lru_b_a[j], lru_w_x[j], lru_b_x[j],
                                 lru_lambda[j], lru_w_out[j], need_ctx)
        x = x + gate_l[:, None, :] * rms_norm(y_l, norm_post[i])
        if need_ctx:
            s_ctx = s_ctx + gate_c * rms_norm(y_c, norm_post[i])
    return x
```

```cpp
#include <hip/hip_runtime.h>
#include <hip/hip_cooperative_groups.h>
#include <cstdio>
#include <cstdint>
namespace cg = cooperative_groups;

#define LAS __attribute__((address_space(3)))
typedef unsigned short bf16_t;
typedef short bf16x8 __attribute__((ext_vector_type(8)));
typedef float f32x4 __attribute__((ext_vector_type(4)));
typedef float f32x2 __attribute__((ext_vector_type(2)));
typedef unsigned u32x4 __attribute__((ext_vector_type(4)));
typedef unsigned u32x2 __attribute__((ext_vector_type(2)));

constexpr int DM = 1024, NB = 4, SEQ = 8192, CTXL = 256, TB = SEQ + CTXL  , MROWS = NB * TB  , NCHK = TB / 256  ;
constexpr int RIN = 6144, RV = 2048, LW = 1280, NSEG = TB / 32  ;
constexpr float EPS = 1e-6f;
constexpr int NTHR = 512, NWAVES = 8;
constexpr int LDS_BYTES = 131072 + 256;

constexpr size_t al256(size_t x) { return (x + 255) & ~size_t(255); }
constexpr size_t WS_BAR = 0;
constexpr size_t WS_BAR_BYTES = 16384;
constexpr size_t WS_MOD = WS_BAR + WS_BAR_BYTES;
constexpr size_t WS_ROPE = al256(WS_MOD + 4 * 5 * 3072 * 4);
constexpr size_t WS_ROPET = WS_ROPE + 65536;
constexpr size_t WS_C8SP = WS_ROPET + 65536;
constexpr size_t WS_SMALL = al256(WS_C8SP + 2 * 2 * 1280 * 4);
constexpr int SM_NPRE = 0, SM_NPOST = 4096, SM_GN = 8192, SM_L2D = 12288, SM_CW = 12304, SM_CB = 22544, SM_BA = 25104, SM_BX = 30224, SM_END = 35344;
constexpr size_t WS_XCTX = al256(WS_SMALL + SM_END * 4);
constexpr size_t WS_WRIN = WS_XCTX + 1024ull * 1024 * 4;
constexpr size_t WS_WROUT = WS_WRIN + 2ull * 6144 * 1024 * 2;
constexpr size_t WS_WLIN = WS_WROUT + 2ull * 1024 * 2048 * 2;
constexpr size_t WS_WLG = WS_WLIN + 2ull * 2560 * 1024 * 2;
constexpr size_t WS_WLOUT = WS_WLG + 2ull * 10 * 512 * 128 * 2;
constexpr size_t WS_GZ = WS_WLOUT + 2ull * 1024 * 1280 * 2;
constexpr size_t WS_AGG = WS_GZ + 33792ull * 1280 * 2;
constexpr size_t WS_CARRY = WS_AGG + 2ull * 2 * 264 * 1280 * 8;
constexpr size_t WS_HN = WS_GZ + 33792ull * 2048 * 2;
constexpr size_t WS_R = WS_HN + 33792ull * 1024 * 2;
constexpr size_t WS_QN = WS_R;
constexpr size_t WS_KN = WS_QN + 8448ull * 1024 * 2;
constexpr size_t WS_KDT = WS_KN + 8448ull * 1024 * 2;
constexpr size_t WS_ACAT = WS_KDT + 2ull * 1024 * 8448 * 2;
constexpr size_t WS_BCAT = WS_ACAT + 4ull * 8448 * 768 * 2;
constexpr size_t WS_O = WS_BCAT + 4ull * 33 * 512 * 768 * 2;
constexpr size_t WS_SCTX = WS_O + 8448ull * 2048 * 2;
constexpr size_t WS_VCTX = WS_SCTX + 4ull * 4 * 256 * 256 * 2;
constexpr size_t WS_OCTX = WS_VCTX + 4ull * 4 * 512 * 256 * 2;
constexpr size_t WS_END = WS_OCTX + 4ull * 256 * 2048 * 2;
constexpr size_t WS_XR = WS_R;
constexpr size_t WS_XC = WS_END - 33792ull * 1280 * 2;
constexpr size_t WS_AU = WS_HN;
constexpr size_t WS_Y = WS_R;
static_assert(WS_END <= 536870912ull, "workspace");
static_assert(WS_CARRY + 2ull * 2 * 264 * 1280 * 4 <= WS_HN, "agg/carry fit");
static_assert(WS_AU + 16896ull * 2 * 1280 * 4 <= WS_XC, "AU vs XC");
static_assert(WS_Y + 33792ull * 1024 * 4 <= WS_XC, "Y vs XC");

struct Params {
    const float *x, *c, *ctx, *c_ctx, *mod_w, *mod_b, *norm_pre, *norm_post;
    const float *ret_w_in, *ret_log_decay, *ret_gn, *ret_w_out;
    const float *lru_w_in, *lru_conv_w, *lru_conv_b, *lru_w_a, *lru_b_a, *lru_w_x, *lru_b_x, *lru_lambda, *lru_w_out;
    float* out; unsigned char* ws;
};

__device__ __forceinline__ unsigned pk2(float lo, float hi) { unsigned r; asm("v_cvt_pk_bf16_f32 %0, %1, %2" : "=v"(r) : "v"(lo), "v"(hi)); return r; }
__device__ __forceinline__ float bflo(unsigned u) { return __uint_as_float(u << 16); }
__device__ __forceinline__ float bfhi(unsigned u) { return __uint_as_float(u & 0xffff0000u); }
__device__ __forceinline__ float bf1(bf16_t b) { return __uint_as_float(((unsigned)b) << 16); }
__device__ __forceinline__ float ex2(float x) { return __builtin_amdgcn_exp2f(x); }
__device__ __forceinline__ float fexp(float x) { return __builtin_amdgcn_exp2f(x * 1.4426950408889634f); }
__device__ __forceinline__ float frcp(float x) { return __builtin_amdgcn_rcpf(x); }
__device__ __forceinline__ float sigm(float x) { return frcp(1.f + fexp(-x)); }
__device__ __forceinline__ int ltid() { int t = threadIdx.x; asm volatile("" : "+v"(t)); return t; }
__device__ __forceinline__ int lbid() { int t = blockIdx.x; asm volatile("" : "+s"(t)); return t; }
__device__ __forceinline__ int lgdim() { int t = gridDim.x; asm volatile("" : "+s"(t)); return t; }
template <int CTRL> __device__ __forceinline__ float dpp_f(float v) { return __builtin_bit_cast(float, __builtin_amdgcn_update_dpp(0, __builtin_bit_cast(int, v), CTRL, 0xf, 0xf, true)); }
__device__ __forceinline__ float lane_xor1(float v) { return dpp_f<0xB1>(v); }
__device__ __forceinline__ float wave_sum(float v) {
    v += dpp_f<0xB1>(v); v += dpp_f<0x4E>(v); v += dpp_f<0x141>(v); v += dpp_f<0x140>(v);
    const int vi = __builtin_bit_cast(int, v);
    const float s0 = __builtin_bit_cast(float, __builtin_amdgcn_readlane(vi, 0)), s1 = __builtin_bit_cast(float, __builtin_amdgcn_readlane(vi, 16));
    const float s2 = __builtin_bit_cast(float, __builtin_amdgcn_readlane(vi, 32)), s3 = __builtin_bit_cast(float, __builtin_amdgcn_readlane(vi, 48));
    return (s0 + s1) + (s2 + s3);
}
__device__ __forceinline__ void store8(bf16_t* p, const float (&v)[8]) {
    u32x4 o; o.x = pk2(v[0], v[1]); o.y = pk2(v[2], v[3]); o.z = pk2(v[4], v[5]); o.w = pk2(v[6], v[7]);
    *(u32x4*)p = o;
}
__device__ __forceinline__ void store8s(bf16_t* p, const float (&v)[8], float s) {
    u32x4 o; o.x = pk2(v[0] * s, v[1] * s); o.y = pk2(v[2] * s, v[3] * s); o.z = pk2(v[4] * s, v[5] * s); o.w = pk2(v[6] * s, v[7] * s);
    *(u32x4*)p = o;
}
__device__ __forceinline__ void unpack8(const u32x4 w, float (&v)[8]) {
    v[0] = bflo(w.x); v[1] = bfhi(w.x); v[2] = bflo(w.y); v[3] = bfhi(w.y); v[4] = bflo(w.z); v[5] = bfhi(w.z); v[6] = bflo(w.w); v[7] = bfhi(w.w);
}

constexpr int BM = 256, BK = 64, HALF = 128, HTB = HALF * BK * 2, NXCD = 8, WGM = 4;
__device__ __forceinline__ int lds_byte(int r, int c) { const int st = (r >> 4) * 2 + (c >> 5), rr = r & 15, cc = c & 31, ob = rr * 64 + cc * 2; return st * 1024 + (ob ^ (((ob >> 9) & 1) << 5)); }
__device__ __forceinline__ void stage_rc(int b, int& R, int& C) { const int st = b / 1024, sb = b % 1024, swz = sb ^ (((sb >> 9) & 1) << 5); R = (st >> 1) * 16 + swz / 64; C = (st & 1) * 32 + (swz % 64) / 2; }
__device__ __forceinline__ int perm32(int rho) { const int n = rho >> 4, i = rho & 15; return 8 * (i >> 2) + 4 * n + (i & 3); }

struct Unit { const char* a; const char* b; int t, i0, i1, i2; };

__device__ __forceinline__ void tile_order(int L, int nM, int nN, int& pm, int& pn) {
    const int nwg = nM * nN; int wgid = L;
    { const int q = nwg / NXCD, r = nwg % NXCD, xcd = wgid % NXCD, off = wgid / NXCD; wgid = (xcd < r ? xcd * (q + 1) : r * (q + 1) + (xcd - r) * q) + off; }
    const int nig = WGM * nN, gid = wgid / nig, fm = gid * WGM, gsz = (nM - fm) < WGM ? (nM - fm) : WGM;
    pm = fm + ((wgid % nig) % gsz); pn = (wgid % nig) / gsz;
}

#define ACC_T const f32x4 (&acc)[2][2][4][2]

template <class Epi, class Sched>
__device__ __forceinline__ void gemm_phase(LAS unsigned char* lds, const int K, const int lda, const int ldb, const Sched& S, const Epi& E) {
    const int tid = ltid(), wid = __builtin_amdgcn_readfirstlane(tid >> 6), lane = tid & 63, wr = wid >> 2, wc = wid & 3, fr = lane & 15, fq = lane >> 4;
    const int nt = K / BK;
    unsigned voffA[2], voffB[2];
#pragma unroll
    for (int i = 0; i < 2; ++i) { int R, C; stage_rc(tid * 16 + i * 8192, R, C); const int Rb = Epi::PERM ? ((R & ~31) + perm32(R & 31)) : R;
        voffA[i] = (unsigned)(R * lda + C) * 2u; voffB[i] = (unsigned)(Rb * ldb + C) * 2u; }
    const size_t kstep = (size_t)(BK * 2);
    const size_t hstepA = (size_t)HALF * lda * 2, hstepB = (size_t)HALF * ldb * 2;
    const unsigned ldsw = (unsigned)wid * 1024u;
    const int aoff = lds_byte(wr * 64 + fr, fq * 8), boff = lds_byte(wc * 32 + fr, fq * 8);
#define PG8_SA(b, h) (((b) * 2 + (h)) * HTB)
#define PG8_SB(b, h) ((4 + (b) * 2 + (h)) * HTB)
#define PG8_STAGE(bufoff, gbase, voff) do { _Pragma("unroll") for (int _i = 0; _i < 2; ++_i) \
        __builtin_amdgcn_global_load_lds((const unsigned*)((const char*)(gbase) + (voff)[_i]), (LAS unsigned*)(lds + (bufoff) + ldsw + _i * 8192), 16, 0, 0); } while (0)
#define PG8_LDA(dst, b, h) do { _Pragma("unroll") for (int m = 0; m < 4; ++m) _Pragma("unroll") for (int k = 0; k < 2; ++k) dst[m][k] = *(const LAS bf16x8*)(lds + PG8_SA(b, h) + aoff + m * 2048 + k * 1024); } while (0)
#define PG8_LDB(dst, b, h) do { _Pragma("unroll") for (int n = 0; n < 2; ++n) _Pragma("unroll") for (int k = 0; k < 2; ++k) dst[n][k] = *(const LAS bf16x8*)(lds + PG8_SB(b, h) + boff + n * 2048 + k * 1024); } while (0)
#define PG8_MMA(ai, bj, At, Bt) do { __builtin_amdgcn_s_setprio(1); _Pragma("unroll") for (int m = 0; m < 4; ++m) _Pragma("unroll") for (int n = 0; n < 2; ++n) _Pragma("unroll") for (int k = 0; k < 2; ++k) \
        acc[ai][bj][m][n] = __builtin_amdgcn_mfma_f32_16x16x32_bf16(Bt[n][k], At[m][k], acc[ai][bj][m][n], 0, 0, 0); __builtin_amdgcn_s_setprio(0); } while (0)
#define PG8_WAIT_V(n) asm volatile("s_waitcnt vmcnt(" #n ")" ::: "memory")
#define PG8_WAIT_L(n) asm volatile("s_waitcnt lgkmcnt(" #n ")" ::: "memory")
#define PG8_BAR __builtin_amdgcn_s_barrier()
#define PG8_SCHED __builtin_amdgcn_sched_barrier(0)
    Unit cur, nxt; int ui = 0;
    if (!S.next(0, cur)) return;
    f32x4 acc[2][2][4][2];
#pragma unroll
    for (int a = 0; a < 2; ++a)
#pragma unroll
        for (int b = 0; b < 2; ++b)
#pragma unroll
            for (int m = 0; m < 4; ++m)
#pragma unroll
                for (int n = 0; n < 2; ++n) acc[a][b][m][n] = (f32x4){0.f, 0.f, 0.f, 0.f};
    bf16x8 At[4][2], B0[2][2], B1[2][2];
    const char* cA = cur.a; const char* cB = cur.b;
    PG8_STAGE(PG8_SB(0, 0), cB, voffB); PG8_STAGE(PG8_SA(0, 0), cA, voffA); PG8_STAGE(PG8_SB(0, 1), cB + hstepB, voffB); PG8_STAGE(PG8_SA(0, 1), cA + hstepA, voffA);
    if (wr == 1) PG8_BAR;
    PG8_WAIT_V(4); PG8_BAR;
    PG8_STAGE(PG8_SB(1, 0), cB + kstep, voffB); PG8_STAGE(PG8_SA(1, 0), cA + kstep, voffA); PG8_STAGE(PG8_SB(1, 1), cB + hstepB + kstep, voffB);
    PG8_WAIT_V(6); PG8_BAR;
    for (;;) {
        const bool has_next = S.next(ui + 1, nxt);
        const char* nA = has_next ? nxt.a : cA; const char* nB = has_next ? nxt.b : cB;
        for (int t = 0; t < nt; t += 2) {
            const bool last = (t == nt - 2);
            const char* a1 = cA + (size_t)(t + 1) * kstep;
            const char* a2 = last ? nA : cA + (size_t)(t + 2) * kstep; const char* b2 = last ? nB : cB + (size_t)(t + 2) * kstep;
            const char* a3 = a2 + kstep; const char* b3 = b2 + kstep;
            PG8_LDB(B0, 0, 0); PG8_SCHED; PG8_LDA(At, 0, 0); PG8_STAGE(PG8_SA(1, 1), a1 + hstepA, voffA);
            PG8_WAIT_L(8); PG8_BAR; PG8_WAIT_L(0); PG8_MMA(0, 0, At, B0); PG8_BAR; PG8_SCHED;
            PG8_LDB(B1, 0, 1); PG8_STAGE(PG8_SB(0, 0), b2, voffB);
            PG8_BAR; PG8_WAIT_L(0); PG8_MMA(0, 1, At, B1); PG8_BAR;
            PG8_LDA(At, 0, 1); PG8_STAGE(PG8_SA(0, 0), a2, voffA);
            PG8_BAR; PG8_WAIT_L(0); PG8_MMA(1, 0, At, B0); PG8_BAR; PG8_SCHED;
            PG8_STAGE(PG8_SB(0, 1), b2 + hstepB, voffB);
            PG8_WAIT_V(6); PG8_BAR; PG8_MMA(1, 1, At, B1); PG8_BAR;
            PG8_LDB(B0, 1, 0); PG8_SCHED; PG8_LDA(At, 1, 0); PG8_STAGE(PG8_SA(0, 1), a2 + hstepA, voffA);
            PG8_WAIT_L(8); PG8_BAR; PG8_WAIT_L(0); PG8_MMA(0, 0, At, B0); PG8_BAR; PG8_SCHED;
            PG8_LDB(B1, 1, 1); PG8_STAGE(PG8_SB(1, 0), b3, voffB);
            PG8_BAR; PG8_WAIT_L(0); PG8_MMA(0, 1, At, B1); PG8_BAR;
            PG8_LDA(At, 1, 1); PG8_STAGE(PG8_SA(1, 0), a3, voffA);
            PG8_BAR; PG8_WAIT_L(0); PG8_MMA(1, 0, At, B0); PG8_BAR; PG8_SCHED;
            PG8_STAGE(PG8_SB(1, 1), b3 + hstepB, voffB);
            PG8_WAIT_V(6); PG8_BAR; PG8_MMA(1, 1, At, B1); PG8_BAR;
        }
        E(acc, cur, wr, wc, fr, fq);
        if (!has_next) break;
#pragma unroll
        for (int a = 0; a < 2; ++a)
#pragma unroll
            for (int b = 0; b < 2; ++b)
#pragma unroll
                for (int m = 0; m < 4; ++m)
#pragma unroll
                    for (int n = 0; n < 2; ++n) acc[a][b][m][n] = (f32x4){0.f, 0.f, 0.f, 0.f};
        cur = nxt; cA = nA; cB = nB; ++ui;
    }
    PG8_WAIT_V(0);
    if (wr == 0) PG8_BAR;
    PG8_BAR;
#undef PG8_SA
#undef PG8_SB
#undef PG8_STAGE
#undef PG8_LDA
#undef PG8_LDB
#undef PG8_MMA
#undef PG8_WAIT_V
#undef PG8_WAIT_L
#undef PG8_BAR
#undef PG8_SCHED
}

#define GET8(v, ai, bj, m) float v[8]; { const f32x4 _a = acc[ai][bj][m][0], _b = acc[ai][bj][m][1]; v[0] = _a.x; v[1] = _a.y; v[2] = _a.z; v[3] = _a.w; v[4] = _b.x; v[5] = _b.y; v[6] = _b.z; v[7] = _b.w; }
#define FOR_AI_M _Pragma("unroll") for (int ai = 0; ai < 2; ++ai) _Pragma("unroll") for (int m = 0; m < 4; ++m)
#define FOR_BJ _Pragma("unroll") for (int bj = 0; bj < 2; ++bj)

__device__ __forceinline__ float lg2dec(const float* ld, int j, int dir, int h) { return ld[j * 8 + dir * 4 + h]; }

__device__ __forceinline__ void rot2(float& e, float& o, float c, float s) { const float te = e, to = o; e = te * c - to * s; o = te * s + to * c; }

struct SchedRetIn {
    int G, c; unsigned char* ws; int j, b;
    __device__ __forceinline__ bool next(int i, Unit& u) const {
        const int L = i * G + c; if (L >= 792) return false;
        size_t z_ = 0; asm volatile("" : "+s"(z_)); unsigned char* w_ = ws + z_;
        const char* hn = (const char*)(w_ + WS_HN) + (size_t)b * TB * 1024 * 2; const char* w = (const char*)(w_ + WS_WRIN) + (size_t)j * RIN * 1024 * 2;
        if (L < 528) { int pm, pn; tile_order(L, 33, 16, pm, pn); u.t = 0; u.i0 = pm; u.i1 = pn;
            u.a = hn + (size_t)pm * 256 * 1024 * 2; u.b = w + (size_t)((pn < 8 ? pn : pn + 8) * 256) * 1024 * 2; }
        else { int pm, pn; tile_order(L - 528, 8, 33, pm, pn); pm += 4; u.t = 1; u.i0 = pm; u.i1 = pn;
            u.a = w + (size_t)(1024 + pm * 256) * 1024 * 2; u.b = hn + (size_t)pn * 256 * 1024 * 2; }
        u.i2 = 0; return true;
    }
};
struct EpiRetIn {
    static constexpr bool PERM = true;
    unsigned char* ws; int j, b;
    __device__ __forceinline__ void operator()(ACC_T, const Unit& u, int wr_, int wc_, int fr, int fq) const {
        int wr = wr_, wc = wc_; asm volatile("" : "+v"(wr), "+v"(wc));
        size_t z_ = 0; asm volatile("" : "+s"(z_)); unsigned char* w_ = ws + z_;
        bf16_t* Qn = (bf16_t*)(w_ + WS_QN); bf16_t* Kn = (bf16_t*)(w_ + WS_KN); bf16_t* KdT = (bf16_t*)(w_ + WS_KDT); bf16_t* Acat = (bf16_t*)(w_ + WS_ACAT); bf16_t* Bcat = (bf16_t*)(w_ + WS_BCAT);
        bf16_t* G = (bf16_t*)(w_ + WS_GZ) + (size_t)b * TB * 2048;
        const f32x2* rope = (const f32x2*)(w_ + WS_ROPE); const f32x2* ropeT = (const f32x2*)(w_ + WS_ROPET); const float* ld = (const float*)(w_ + WS_SMALL) + SM_L2D;
        const int c8 = 32 * wc + 8 * fq;
        if (u.t == 0) {
            const int pm = u.i0, pn = u.i1;
            if (pn >= 8) {
                bf16_t* gp = G + (size_t)(pm * 256) * 2048 + (pn - 8) * 256 + c8;
                FOR_AI_M { const int r = 128 * ai + 64 * wr + 16 * m + fr;
                    FOR_BJ { GET8(v, ai, bj, m); store8(gp + (size_t)r * 2048 + 128 * bj, v); __builtin_amdgcn_sched_barrier(0); } }
            } else {
                const int h = pn & 3; const bool isq = pn < 4, lat = pm > 0;
                const float lf = lg2dec(ld, j, 0, h), lb = lg2dec(ld, j, 1, h);
                const int li = fr & 7, lg8 = fr >> 3;
                float ftq[8], btq[8];
                if (!isq) {
#pragma unroll
                    for (int q = 0; q < 8; ++q) { ftq[q] = ex2(-lf * (float)q); btq[q] = ex2(lb * (float)q); }
                }
                FOR_AI_M { const int r = 128 * ai + 64 * wr + 16 * m + fr, pos = pm * 256 + r, t = pos - 256, rg = t >> 6, cgc = t & 63;
                    const float df = ex2(lf * (float)(r + 1)), db = ex2(lb * (float)(256 - r));
                    FOR_BJ { GET8(v, ai, bj, m);
                        if (lat) { const int p = bj ? cgc : rg; const f32x4* cs = (const f32x4*)(rope + p * 64 + (c8 >> 1)); const f32x4 c01 = cs[0], c23 = cs[1];
                            rot2(v[0], v[1], c01.x, c01.y); rot2(v[2], v[3], c01.z, c01.w); rot2(v[4], v[5], c23.x, c23.y); rot2(v[6], v[7], c23.z, c23.w); }
                        const int d0 = 128 * bj + c8;
                        if (isq) {
                            bf16_t* ap = Acat + ((size_t)h * TB + pos) * 768 + d0; store8s(ap + 256, v, df); store8s(ap + 512, v, db); }
                        else { store8s(Kn + (size_t)pos * 1024 + h * 256 + d0, v, 0.0625f);
#define XCH(A, B, BIT, FA, FB) { const float pa_ = FA, pb_ = FB; if (li & BIT) A = pb_; else B = pa_; }
                            XCH(v[0], v[1], 1, dpp_f<0xB1>(v[0]), dpp_f<0xB1>(v[1])) XCH(v[2], v[3], 1, dpp_f<0xB1>(v[2]), dpp_f<0xB1>(v[3]))
                            XCH(v[4], v[5], 1, dpp_f<0xB1>(v[4]), dpp_f<0xB1>(v[5])) XCH(v[6], v[7], 1, dpp_f<0xB1>(v[6]), dpp_f<0xB1>(v[7]))
                            XCH(v[0], v[2], 2, dpp_f<0x4E>(v[0]), dpp_f<0x4E>(v[2])) XCH(v[1], v[3], 2, dpp_f<0x4E>(v[1]), dpp_f<0x4E>(v[3]))
                            XCH(v[4], v[6], 2, dpp_f<0x4E>(v[4]), dpp_f<0x4E>(v[6])) XCH(v[5], v[7], 2, dpp_f<0x4E>(v[5]), dpp_f<0x4E>(v[7]))
#define X4(x) dpp_f<0x1B>(dpp_f<0x141>(x))
                            XCH(v[0], v[4], 4, X4(v[0]), X4(v[4])) XCH(v[1], v[5], 4, X4(v[1]), X4(v[5]))
                            XCH(v[2], v[6], 4, X4(v[2]), X4(v[6])) XCH(v[3], v[7], 4, X4(v[3]), X4(v[7]))
#undef X4
#undef XCH
                            const int rt0 = 128 * ai + 64 * wr + 16 * m + 8 * lg8;
                            const float fb = ex2(lf * (float)(255 - rt0)) * 0.0625f, bbs = ex2(lb * (float)rt0) * 0.0625f;
                            float vf[8], vb[8];
#pragma unroll
                            for (int q = 0; q < 8; ++q) { vf[q] = v[q] * (fb * ftq[q]); vb[q] = v[q] * (bbs * btq[q]); }
                            store8(KdT + ((size_t)(h * NCHK + pm) * 256 + d0 + li) * 256 + rt0, vf); store8(KdT + ((size_t)((4 + h) * NCHK + pm) * 256 + d0 + li) * 256 + rt0, vb);
                        }
                        __builtin_amdgcn_sched_barrier(0);
                    } }
            }
        } else {
            const int pm = u.i0, pn = u.i1;
            if (pm >= 4) {
                const int h = (pm - 4) >> 1, e0 = ((pm - 4) & 1) * 256;
                bf16_t* bp = Bcat + ((size_t)(h * NCHK + pn) * 512 + e0) * 768 + c8;
                bf16_t* vp = (bf16_t*)(w_ + WS_VCTX) + ((size_t)(b * 4 + h) * 512 + e0) * 256 + c8;
                FOR_AI_M { const int r = 128 * ai + 64 * wr + 16 * m + fr;
                    FOR_BJ { GET8(v, ai, bj, m); store8(bp + (size_t)r * 768 + 128 * bj, v); if (pn == 0) store8(vp + (size_t)r * 256 + 128 * bj, v); __builtin_amdgcn_sched_barrier(0); } }
            }
        }
    }
};

struct SchedS {
    int G, c; unsigned char* ws;
    __device__ __forceinline__ bool next(int i, Unit& u) const {
        const int L = i * G + c; if (L >= 132) return false;
        size_t z_ = 0; asm volatile("" : "+s"(z_)); unsigned char* w_ = ws + z_;
        const char* kn = (const char*)(w_ + WS_KN);
        const int h = L & 3, ch = L >> 2; const size_t off = ((size_t)ch * 256 * 1024 + h * 256) * 2;
        u.a = (const char*)(w_ + WS_ACAT) + (((size_t)h * TB + ch * 256) * 768 + 256) * 2;
        u.b = kn + off; u.t = 0; u.i0 = h; u.i1 = ch; u.i2 = 0; return true;
    }
};
struct EpiS {
    static constexpr bool PERM = true;
    unsigned char* ws; int j, b;
    __device__ __forceinline__ void operator()(ACC_T, const Unit& u, int wr_, int wc_, int fr, int fq) const {
        int wr = wr_, wc = wc_; asm volatile("" : "+v"(wr), "+v"(wc));
        size_t z_ = 0; asm volatile("" : "+s"(z_)); unsigned char* w_ = ws + z_;
        bf16_t* Acat = (bf16_t*)(w_ + WS_ACAT); const float* ld = (const float*)(w_ + WS_SMALL) + SM_L2D;
        const int h = u.i0, ch = u.i1, c8 = 32 * wc + 8 * fq;
        const float lf = lg2dec(ld, j, 0, h), lb = lg2dec(ld, j, 1, h);
        const int rs_ = ch == 0 ? 256 : 768;
        bf16_t* ap = (ch == 0 ? (bf16_t*)(w_ + WS_SCTX) + (size_t)(b * 4 + h) * 65536 : Acat + ((size_t)h * TB + ch * 256) * 768) + c8;
        float cfm[2][8], cbm[2][8];
#pragma unroll
        for (int bj = 0; bj < 2; ++bj)
#pragma unroll
            for (int q = 0; q < 8; ++q) { const float mm = (float)(128 * bj + c8 + q); cfm[bj][q] = ex2(-lf * (mm + 1.f)); cbm[bj][q] = ex2(lb * mm); }
        FOR_AI_M { const int n = 128 * ai + 64 * wr + 16 * m + fr; const float nf = (float)n;
            const float rbn = ex2(-(lf + lb) * nf - lf), dgn = 2.f * ex2(-lf * (nf + 1.f));
            FOR_BJ { GET8(v, ai, bj, m); const int m0 = 128 * bj + c8;
#pragma unroll
                for (int q = 0; q < 8; ++q) { const int dl = n - (m0 + q); const float fac = dl > 0 ? cfm[bj][q] : (dl < 0 ? cbm[bj][q] * rbn : dgn); v[q] *= fac; }
                store8(ap + (size_t)n * rs_ + 128 * bj, v); __builtin_amdgcn_sched_barrier(0); } }
    }
};

struct SchedLoc {
    int G, c; unsigned char* ws;
    __device__ __forceinline__ bool next(int i, Unit& u) const {
        const int L = i * G + c; if (L >= 512) return false;
        size_t z_ = 0; asm volatile("" : "+s"(z_)); unsigned char* w_ = ws + z_;
        const char* bcat = (const char*)(w_ + WS_BCAT); const char* kdt = (const char*)(w_ + WS_KDT);
        const int eh = L & 1, dir = (L >> 1) & 1, h = (L >> 2) & 3, k = L >> 4, ch = (dir == 0 || k == 0) ? k : k + 1;
        u.a = bcat + ((size_t)(h * NCHK + ch) * 512 + eh * 256) * 768 * 2;
        u.b = kdt + (size_t)((dir * 4 + h) * NCHK + ch) * 65536 * 2;
        u.t = eh; u.i0 = h; u.i1 = ch; u.i2 = dir; return true;
    }
};
struct EpiLoc {
    static constexpr bool PERM = true;
    unsigned char* ws;
    __device__ __forceinline__ void operator()(ACC_T, const Unit& u, int wr_, int wc_, int fr, int fq) const {
        int wr = wr_, wc = wc_; asm volatile("" : "+v"(wr), "+v"(wc));
        size_t z_ = 0; asm volatile("" : "+s"(z_)); unsigned char* w_ = ws + z_;
        bf16_t* Bcat = (bf16_t*)(w_ + WS_BCAT);
        const int c8 = 32 * wc + 8 * fq;
        bf16_t* bp = Bcat + ((size_t)(u.i0 * NCHK + u.i1) * 512 + u.t * 256) * 768 + 256 + u.i2 * 256 + c8;
        FOR_AI_M { const int r = 128 * ai + 64 * wr + 16 * m + fr;
            FOR_BJ { GET8(v, ai, bj, m); store8(bp + (size_t)r * 768 + 128 * bj, v); __builtin_amdgcn_sched_barrier(0); } }
    }
};

struct SchedO {
    int G, c; unsigned char* ws; int small;
    __device__ __forceinline__ bool next(int i, Unit& u) const {
        const int L = i * G + c; if (L >= (small ? 32 : 256)) return false;
        size_t z_ = 0; asm volatile("" : "+s"(z_)); unsigned char* w_ = ws + z_;
        const char* acat = (const char*)(w_ + WS_ACAT); const char* bcat = (const char*)(w_ + WS_BCAT);
        const int nh = L & 1, h = (L >> 1) & 3, ch = small ? 0 : 1 + (L >> 3), bb = L >> 3;
        if (small) { u.a = (const char*)(w_ + WS_SCTX) + (size_t)(bb * 4 + h) * 65536 * 2; u.b = (const char*)(w_ + WS_VCTX) + ((size_t)(bb * 4 + h) * 512 + nh * 256) * 256 * 2; u.t = nh; u.i0 = h; u.i1 = 0; u.i2 = bb; return true; }
        u.a = acat + ((size_t)h * TB + ch * 256) * 768 * 2;
        u.b = bcat + ((size_t)(h * NCHK + ch) * 512 + nh * 256) * 768 * 2;
        u.t = nh; u.i0 = h; u.i1 = ch; u.i2 = 0; return true;
    }
};
struct EpiO {
    static constexpr bool PERM = true;
    unsigned char* ws;
    __device__ __forceinline__ void operator()(ACC_T, const Unit& u, int wr_, int wc_, int fr, int fq) const {
        int wr = wr_, wc = wc_; asm volatile("" : "+v"(wr), "+v"(wc));
        size_t z_ = 0; asm volatile("" : "+s"(z_)); unsigned char* w_ = ws + z_;
        bf16_t* O = u.i1 == 0 ? (bf16_t*)(w_ + WS_OCTX) + (size_t)u.i2 * 256 * 2048 : (bf16_t*)(w_ + WS_O) + (size_t)(u.i1 * 256) * 2048;
        const int c8 = 32 * wc + 8 * fq;
        bf16_t* op = O + u.i0 * 512 + u.t * 256 + c8;
        FOR_AI_M { const int r = 128 * ai + 64 * wr + 16 * m + fr;
            FOR_BJ { GET8(v, ai, bj, m); store8(op + (size_t)r * 2048 + 128 * bj, v); __builtin_amdgcn_sched_barrier(0); } }
    }
};

struct SchedPlain {
    int G, c, nN, K; unsigned char* ws; size_t aoff, boff; int skipctx;
    __device__ __forceinline__ bool next(int i, Unit& u) const {
        const int nM = skipctx ? 128 : 132;
        const int L = i * G + c; if (L >= nM * nN) return false;
        size_t z_ = 0; asm volatile("" : "+s"(z_)); unsigned char* w_ = ws + z_;
        const char* a = (const char*)(w_ + aoff); const char* b = (const char*)(w_ + boff);
        int pm, pn; tile_order(L, nM, nN, pm, pn);
        if (skipctx) pm = (pm >> 5) * 33 + 1 + (pm & 31);
        u.a = a + (size_t)pm * 256 * K * 2; u.b = b + (size_t)pn * 256 * K * 2; u.t = 0; u.i0 = pm; u.i1 = pn; u.i2 = 0; return true;
    }
};
struct EpiY {
    static constexpr bool PERM = true;
    unsigned char* ws;
    __device__ __forceinline__ void operator()(ACC_T, const Unit& u, int wr_, int wc_, int fr, int fq) const {
        int wr = wr_, wc = wc_; asm volatile("" : "+v"(wr), "+v"(wc));
        size_t z_ = 0; asm volatile("" : "+s"(z_)); unsigned char* w_ = ws + z_;
        bf16_t* Y = (bf16_t*)(w_ + WS_Y);
        const int c8 = 32 * wc + 8 * fq;
        bf16_t* yp = Y + (size_t)(u.i0 * 256) * 1024 + u.i1 * 256 + c8;
        FOR_AI_M { const int r = 128 * ai + 64 * wr + 16 * m + fr;
            FOR_BJ { GET8(v, ai, bj, m); store8(yp + (size_t)r * 1024 + 128 * bj, v); __builtin_amdgcn_sched_barrier(0); } }
    }
};
struct EpiLruIn {
    static constexpr bool PERM = true;
    unsigned char* ws;
    __device__ __forceinline__ void operator()(ACC_T, const Unit& u, int wr_, int wc_, int fr, int fq) const {
        int wr = wr_, wc = wc_; asm volatile("" : "+v"(wr), "+v"(wc));
        size_t z_ = 0; asm volatile("" : "+s"(z_)); unsigned char* w_ = ws + z_;
        bf16_t* XR = (bf16_t*)(w_ + WS_XR); bf16_t* GL = (bf16_t*)(w_ + WS_GZ);
        const int pm = u.i0, pn = u.i1, c8 = 32 * wc + 8 * fq;
        bf16_t* dp = (pn < 5 ? XR + pn * 256 : GL + (pn - 5) * 256) + (size_t)(pm * 256) * LW + c8;
        FOR_AI_M { const int r = 128 * ai + 64 * wr + 16 * m + fr;
            FOR_BJ { GET8(v, ai, bj, m); store8(dp + (size_t)r * LW + 128 * bj, v); __builtin_amdgcn_sched_barrier(0); } }
    }
};

struct SchedGate {
    int G, c; unsigned char* ws; int j, hf;
    __device__ __forceinline__ bool next(int i, Unit& u) const {
        const int L = i * G + c; if (L >= 1320) return false;
        size_t z_ = 0; asm volatile("" : "+s"(z_)); unsigned char* w_ = ws + z_;
        const char* xc = (const char*)(w_ + WS_XC) + (size_t)hf * 2 * TB * LW * 2; const char* wg = (const char*)(w_ + WS_WLG) + (size_t)j * 10 * 512 * 128 * 2;
        const int dir = L & 1, nb = (L >> 1) % 10, pm = L / 20;
        u.a = xc + ((size_t)pm * 256 * LW + nb * 128) * 2; u.b = wg + (size_t)(nb * 512 + dir * 256) * 128 * 2;
        u.t = dir; u.i0 = pm; u.i1 = nb; u.i2 = 0; return true;
    }
};
struct EpiGate {
    static constexpr bool PERM = false;
    unsigned char* ws; int j, hf;
    __device__ __forceinline__ void operator()(ACC_T, const Unit& u, int wr_, int wc_, int fr, int fq) const {
        int wr = wr_, wc = wc_; asm volatile("" : "+v"(wr), "+v"(wc));
        size_t z_ = 0; asm volatile("" : "+s"(z_)); unsigned char* w_ = ws + z_;
        const bf16_t* XC = (const bf16_t*)(w_ + WS_XC) + (size_t)hf * 2 * TB * LW; unsigned* AU = (unsigned*)(w_ + WS_AU);
        const float* sm_ = (const float*)(w_ + WS_SMALL); const float* ba = sm_ + SM_BA + j * 2 * LW; const float* bx = sm_ + SM_BX + j * 2 * LW; const float* c8 = (const float*)(w_ + WS_C8SP) + j * 2 * LW;
        const int dir = u.t, pm = u.i0, nb = u.i1;
        u32x2 xall[2][2][4]; f32x4 pv_[2][3];
#pragma unroll
        for (int nn = 0; nn < 2; ++nn) {
            const int ch0 = nb * 128 + 32 * wc + 16 * nn + 4 * fq;
            pv_[nn][0] = *(const f32x4*)(ba + dir * LW + ch0); pv_[nn][1] = *(const f32x4*)(bx + dir * LW + ch0); pv_[nn][2] = *(const f32x4*)(c8 + dir * LW + ch0);
            FOR_AI_M { const int lrow = pm * 256 + 128 * ai + 64 * wr + 16 * m + fr; xall[nn][ai][m] = *(const u32x2*)(XC + (size_t)lrow * LW + ch0); }
        }
        __builtin_amdgcn_sched_barrier(0);
#pragma unroll
        for (int nn = 0; nn < 2; ++nn) {
            const int ch0 = nb * 128 + 32 * wc + 16 * nn + 4 * fq;
            const f32x4 vba = pv_[nn][0], vbx = pv_[nn][1], vc8 = pv_[nn][2];
            FOR_AI_M { const int lrow = pm * 256 + 128 * ai + 64 * wr + 16 * m + fr;
                const u32x2 xw = xall[nn][ai][m];
                const float xc0 = bflo(xw.x), xc1 = bfhi(xw.x), xc2 = bflo(xw.y), xc3 = bfhi(xw.y);
                const f32x4 pa = acc[ai][0][m][nn] + vba, px = acc[ai][1][m][nn] + vbx;
                u32x4 o;
#define GATE2(PA0, PA1, PX0, PX1, C80, C81, XC0, XC1, OUT0, OUT1) { \
                    f32x2 na = (f32x2){fminf(-(PA0), 40.f), fminf(-(PA1), 40.f)} * 1.4426950408889634f, nx = (f32x2){fminf(-(PX0), 40.f), fminf(-(PX1), 40.f)} * 1.4426950408889634f; \
                    f32x2 ea = (f32x2){ex2(na.x), ex2(na.y)} + 1.f, exx = (f32x2){ex2(nx.x), ex2(nx.y)} + 1.f; const f32x2 pr = ea * exx; \
                    const f32x2 t = (f32x2){frcp(pr.x), frcp(pr.y)}; const f32x2 la = (t * exx) * (f32x2){C80, C81}, gi = t * ea; \
                    const f32x2 e1 = la * 1.4426950408889634f; const f32x2 av = (f32x2){ex2(e1.x), ex2(e1.y)}; const f32x2 om = 1.f - av * av, oma = 1.f - av; \
                    const f32x2 uu = ((f32x2){__builtin_amdgcn_sqrtf(fmaxf(om.x, 0.f)), __builtin_amdgcn_sqrtf(fmaxf(om.y, 0.f))} * gi) * (f32x2){XC0, XC1}; \
                    OUT0 = pk2(oma.x, uu.x); OUT1 = pk2(oma.y, uu.y); }
                GATE2(pa.x, pa.y, px.x, px.y, vc8.x, vc8.y, xc0, xc1, o.x, o.y) GATE2(pa.z, pa.w, px.z, px.w, vc8.z, vc8.w, xc2, xc3, o.z, o.w)
#undef GATE2
                *(u32x4*)(AU + ((size_t)lrow * 2 + dir) * LW + ch0) = o;
                __builtin_amdgcn_sched_barrier(0);
            }
        }
    }
};

__device__ __forceinline__ void transpose_item(const float* W, int N, bf16_t* WT, int ldt, LAS float* scr, int kb, int nb, int lane) {
    const int k0 = 64 * kb, n0 = 32 * nb;
    float tv[32];
#pragma unroll
    for (int i = 0; i < 32; ++i) { const int kk = 2 * i + (lane >> 5); tv[i] = W[(size_t)(k0 + kk) * N + n0 + (lane & 31)]; }
#pragma unroll
    for (int i = 0; i < 32; ++i) { const int kk = 2 * i + (lane >> 5); scr[kk * 33 + (lane & 31)] = tv[i]; }
    asm volatile("s_waitcnt lgkmcnt(0)" ::: "memory");
    const int c = lane & 7;
#pragma unroll
    for (int jj = 0; jj < 4; ++jj) { const int n = (lane >> 3) + 8 * jj; const LAS float* s = scr + (8 * c) * 33 + n;
        u32x4 o; o.x = pk2(s[0 * 33], s[1 * 33]); o.y = pk2(s[2 * 33], s[3 * 33]); o.z = pk2(s[4 * 33], s[5 * 33]); o.w = pk2(s[6 * 33], s[7 * 33]);
        *(u32x4*)(WT + (size_t)(n0 + n) * ldt + k0 + 8 * c) = o; }
    asm volatile("s_waitcnt lgkmcnt(0)" ::: "memory");
}

__device__ __forceinline__ void phase0(const Params& P, LAS unsigned char* lds) {
    const int tid = ltid(), lane = tid & 63, wave = tid >> 6, bidx = lbid(), gdim = lgdim();
    const int gw = bidx * NWAVES + wave, NGW = gdim * NWAVES;
    unsigned char* ws = P.ws;
    {
        LAS float* scr = (LAS float*)(lds + wave * 8704);
        constexpr int I_RIN = 16 * 192, I_ROUT = 32 * 32, I_LIN = 16 * 80, I_LOUT = 20 * 32, I_G = 8;
        constexpr int NIT = 2 * I_RIN + 2 * I_ROUT + 2 * I_LIN + 2 * I_LOUT + 80 * I_G;
        for (int it = gw; it < NIT; it += NGW) {
            int r = it;
            if (r < 2 * I_RIN) { const int jj = r / I_RIN; r %= I_RIN; transpose_item(P.ret_w_in + (size_t)jj * 1024 * RIN, RIN, (bf16_t*)(ws + WS_WRIN) + (size_t)jj * RIN * 1024, 1024, scr, r / 192, r % 192, lane); continue; } r -= 2 * I_RIN;
            if (r < 2 * I_ROUT) { const int jj = r / I_ROUT; r %= I_ROUT; transpose_item(P.ret_w_out + (size_t)jj * RV * 1024, 1024, (bf16_t*)(ws + WS_WROUT) + (size_t)jj * 1024 * RV, RV, scr, r / 32, r % 32, lane); continue; } r -= 2 * I_ROUT;
            if (r < 2 * I_LIN) { const int jj = r / I_LIN; r %= I_LIN; transpose_item(P.lru_w_in + (size_t)jj * 1024 * 2560, 2560, (bf16_t*)(ws + WS_WLIN) + (size_t)jj * 2560 * 1024, 1024, scr, r / 80, r % 80, lane); continue; } r -= 2 * I_LIN;
            if (r < 2 * I_LOUT) { const int jj = r / I_LOUT; r %= I_LOUT; transpose_item(P.lru_w_out + (size_t)jj * LW * 1024, 1024, (bf16_t*)(ws + WS_WLOUT) + (size_t)jj * 1024 * LW, LW, scr, r / 32, r % 32, lane); continue; } r -= 2 * I_LOUT;
            {
                const int mat = r / I_G, sub = r % I_G; const int nb = mat % 10, gate = (mat / 10) & 1, dir = (mat / 20) & 1, jj = mat / 40;
                const float* src = (gate ? P.lru_w_x : P.lru_w_a) + ((size_t)((jj * 2 + dir) * 10 + nb)) * 128 * 128;
                bf16_t* dst = (bf16_t*)(ws + WS_WLG) + ((size_t)(jj * 10 + nb) * 512 + dir * 256 + gate * 128) * 128;
                transpose_item(src, 128, dst, 128, scr, sub / 4, sub % 4, lane);
            }
        }
    }
    {
        const int gt = bidx * NTHR + tid, NGT = gdim * NTHR;
        f32x2* rope = (f32x2*)(ws + WS_ROPE); f32x2* ropeT = (f32x2*)(ws + WS_ROPET); float* c8 = (float*)(ws + WS_C8SP);
        for (int i = gt; i < 128 * 64; i += NGT) { const int p = i >> 6, f = i & 63;
            const float inv = powf(10000.f, -(float)f / 64.f); const float ang = (float)p * inv; float sn, cs; sincosf(ang, &sn, &cs);
            rope[p * 64 + f] = (f32x2){cs, sn}; ropeT[f * 128 + p] = (f32x2){cs, sn}; }
        for (int i = gt; i < 2 * 2 * LW; i += NGT) { const float lam = P.lru_lambda[i]; c8[i] = -8.f * log1pf(expf(-lam)); }
        float* sm = (float*)(ws + WS_SMALL);
        for (int i = gt; i < SM_END; i += NGT) {
            float v;
            if (i < SM_NPOST) v = P.norm_pre[i];
            else if (i < SM_GN) v = P.norm_post[i - SM_NPOST];
            else if (i < SM_L2D) v = P.ret_gn[i - SM_GN];
            else if (i < SM_CW) v = -fabsf(P.ret_log_decay[i - SM_L2D]) * 1.4426950408889634f;
            else if (i < SM_CB) v = P.lru_conv_w[i - SM_CW];
            else if (i < SM_BA) v = P.lru_conv_b[i - SM_CB];
            else if (i < SM_BX) v = P.lru_b_a[i - SM_BA];
            else v = P.lru_b_x[i - SM_BX];
            sm[i] = v;
        }
    }
    __syncthreads();
    {
        LAS float* act = (LAS float*)lds;
        LAS float* red = (LAS float*)(lds + 5 * 1024 * 4);
        float* modv = (float*)(ws + WS_MOD);
        bool have_act = false;
        for (int task = bidx; task < 4 * 48; task += gdim) {
            const int layer = task / 48, nt = task % 48;
            if (!have_act) {
                __syncthreads();
                for (int i = tid; i < 5 * 1024; i += NTHR) { const float cv = i < 4096 ? P.c[i] : P.c_ctx[i - 4096]; act[i] = cv / (1.f + expf(-cv)); }
                __syncthreads(); have_act = true;
            }
            const int n = tid & 63, ks = tid >> 6;
            const float* wp = P.mod_w + ((size_t)layer * 1024 + ks * 128) * 3072 + nt * 64 + n;
            float a0 = 0.f, a1 = 0.f, a2 = 0.f, a3 = 0.f, a4 = 0.f;
#pragma unroll 32
            for (int k = 0; k < 128; ++k) { const float w = wp[(size_t)k * 3072]; const int kk = ks * 128 + k;
                a0 += act[kk] * w; a1 += act[1024 + kk] * w; a2 += act[2048 + kk] * w; a3 += act[3072 + kk] * w; a4 += act[4096 + kk] * w; }
            red[(ks * 5 + 0) * 64 + n] = a0; red[(ks * 5 + 1) * 64 + n] = a1; red[(ks * 5 + 2) * 64 + n] = a2; red[(ks * 5 + 3) * 64 + n] = a3; red[(ks * 5 + 4) * 64 + n] = a4;
            __syncthreads();
            if (tid < 320) { const int s = tid >> 6, nn = tid & 63; float sum = 0.f;
#pragma unroll
                for (int q = 0; q < 8; ++q) sum += red[(q * 5 + s) * 64 + nn];
                const int col = nt * 64 + nn; modv[(size_t)(layer * 5 + s) * 3072 + col] = sum + P.mod_b[layer * 3072 + col]; }
            __syncthreads();
        }
    }
    __syncthreads();
}

__device__ __forceinline__ void post_phase(const float* xin, const float* ctxin, float* outp, unsigned char* ws, int layer, LAS unsigned char* lds) {
    const int tid = ltid(), lane = tid & 63, wave = tid >> 6;
    const int gw = lbid() * NWAVES + wave, NGW = lgdim() * NWAVES;
    const float* sm = (const float*)(ws + WS_SMALL);
    const float* modv = (const float*)(ws + WS_MOD);
    const bf16_t* Y = (const bf16_t*)(ws + WS_Y);
    float* xctx = (float*)(ws + WS_XCTX);
    bf16_t* Hn = (bf16_t*)(ws + WS_HN);
    const int nl = layer + 1;
    LAS float* pl = (LAS float*)lds;
    for (int i = tid; i < 5 * 1024; i += NTHR) { const int s = i >> 10, col = i & 1023;
        if (layer >= 0) pl[i] = modv[(size_t)(layer * 5 + s) * 3072 + 2048 + col];
        if (nl < 4) { pl[5120 + i] = modv[(size_t)(nl * 5 + s) * 3072 + col]; pl[10240 + i] = modv[(size_t)(nl * 5 + s) * 3072 + 1024 + col]; } }
    for (int i = tid; i < 1024; i += NTHR) { if (layer >= 0) pl[15360 + i] = sm[SM_NPOST + layer * DM + i]; if (nl < 4) pl[16384 + i] = sm[SM_NPRE + nl * DM + i]; }
    __syncthreads();
#define POST_LOAD(XV, YW, R0) do { _Pragma("unroll") for (int u = 0; u < 2; ++u) { \
            const int row_ = (R0) + u * NGW; const int rowc_ = row_ < MROWS ? row_ : (R0); \
            const int b_ = rowc_ / TB, pos_ = rowc_ - b_ * TB; const bool isctx_ = pos_ < CTXL; \
            const size_t xoff_ = isctx_ ? ((size_t)(b_ * CTXL + pos_) * DM) : ((size_t)(b_ * SEQ + pos_ - CTXL) * DM); \
            const float* xs_ = (layer <= 0) ? (isctx_ ? ctxin + xoff_ : xin + xoff_) : (isctx_ ? xctx + xoff_ : outp + xoff_); \
            _Pragma("unroll") for (int q = 0; q < 4; ++q) XV[u][q] = *(const f32x4*)(xs_ + 4 * lane + 256 * q); \
            if (layer >= 0) { _Pragma("unroll") for (int q = 0; q < 4; ++q) YW[u][q] = *(const u32x2*)(Y + (size_t)rowc_ * DM + 4 * lane + 256 * q); } } } while (0)
    f32x4 xv[2][4]; u32x2 yw[2][4];
    if (gw < MROWS) POST_LOAD(xv, yw, gw);
    for (int row0 = gw; row0 < MROWS; row0 += 2 * NGW) {
        f32x4 xn[2][4]; u32x2 yn[2][4];
        const int nrow0 = row0 + 2 * NGW;
        if (nrow0 < MROWS) POST_LOAD(xn, yn, nrow0);
#pragma unroll
        for (int u = 0; u < 2; ++u) {
            const int row = row0 + u * NGW; const bool valid = row < MROWS; const int rowc = valid ? row : row0;
            const int b = rowc / TB, pos = rowc - b * TB; const bool isctx = pos < CTXL; const int s = isctx ? 4 : b;
            if (!(valid && !(layer == 3 && isctx))) continue;
            const size_t xoff = isctx ? ((size_t)(b * CTXL + pos) * DM) : ((size_t)(b * SEQ + pos - CTXL) * DM);
            float* xd = isctx ? xctx + xoff : outp + xoff;
            if (layer >= 0) {
                f32x4 yv[4]; float ss = 0.f;
#pragma unroll
                for (int q = 0; q < 4; ++q) { yv[q] = (f32x4){bflo(yw[u][q].x), bfhi(yw[u][q].x), bflo(yw[u][q].y), bfhi(yw[u][q].y)}; ss += (yv[q].x * yv[q].x + yv[q].y * yv[q].y) + (yv[q].z * yv[q].z + yv[q].w * yv[q].w); }
                const float rs = __builtin_amdgcn_rsqf(wave_sum(ss) * (1.f / DM) + EPS);
#pragma unroll
                for (int q = 0; q < 4; ++q) { const f32x4 g = *(const LAS f32x4*)(pl + s * 1024 + 4 * lane + 256 * q), w = *(const LAS f32x4*)(pl + 15360 + 4 * lane + 256 * q);
                    xv[u][q] = xv[u][q] + g * (yv[q] * rs * w); *(f32x4*)(xd + 4 * lane + 256 * q) = xv[u][q]; }
            }
            if (nl < 4) {
                float ss = 0.f;
#pragma unroll
                for (int q = 0; q < 4; ++q) ss += (xv[u][q].x * xv[u][q].x + xv[u][q].y * xv[u][q].y) + (xv[u][q].z * xv[u][q].z + xv[u][q].w * xv[u][q].w);
                const float rs = __builtin_amdgcn_rsqf(wave_sum(ss) * (1.f / DM) + EPS);
#pragma unroll
                for (int q = 0; q < 4; ++q) { const f32x4 a = *(const LAS f32x4*)(pl + 5120 + s * 1024 + 4 * lane + 256 * q), c = *(const LAS f32x4*)(pl + 10240 + s * 1024 + 4 * lane + 256 * q), w = *(const LAS f32x4*)(pl + 16384 + 4 * lane + 256 * q);
                    const f32x4 hv = (xv[u][q] * rs * w) * (c + 1.f) + a;
                    u32x2 o; o.x = pk2(hv.x, hv.y); o.y = pk2(hv.z, hv.w);
                    *(u32x2*)(Hn + (size_t)row * DM + 4 * lane + 256 * q) = o; }
            }
        }
#pragma unroll
        for (int u = 0; u < 2; ++u)
#pragma unroll
            for (int q = 0; q < 4; ++q) { xv[u][q] = xn[u][q]; yw[u][q] = yn[u][q]; }
    }
#undef POST_LOAD
    __syncthreads();
}

__device__ __forceinline__ void ret_scan(unsigned char* ws, int j) {
    bf16_t* Bcat = (bf16_t*)(ws + WS_BCAT); const float* l2d = (const float*)(ws + WS_SMALL) + SM_L2D;
    int bid_ = lbid(), ng_ = lgdim();
    if (ng_ > 132 + 32) { if (bid_ < 132) return; bid_ -= 132; ng_ -= 132; }
    const int NGT = ng_ * NTHR; const int gt0 = bid_ * NTHR + ltid();
    for (int idx = gt0; idx < 4 * 512 * 128; idx += NGT) {
        const int u_ = __builtin_amdgcn_readfirstlane(idx >> 6); const int dg = idx & 63, dir = u_ & 1, e = (u_ >> 1) & 511, h = u_ >> 10;
        const float dec = ex2(lg2dec(l2d, j, dir, h) * 256.f);
        bf16_t* base = Bcat + ((size_t)(h * NCHK) * 512 + e) * 768 + 256 + dir * 256 + dg * 4;
        float run[4] = {0.f, 0.f, 0.f, 0.f};
        u32x2 loc[33];
#pragma unroll
        for (int k = 0; k < 33; ++k) { const int ch = dir == 0 ? k : (k == 0 ? 0 : 33 - k); loc[k] = *(const u32x2*)(base + (size_t)ch * 512 * 768); }
#pragma unroll
        for (int k = 0; k < 33; ++k) { const int ch = dir == 0 ? k : (k == 0 ? 0 : 33 - k);
            u32x2 o; o.x = pk2(run[0], run[1]); o.y = pk2(run[2], run[3]);
            *(u32x2*)(base + (size_t)ch * 512 * 768) = o;
            run[0] = run[0] * dec + bflo(loc[k].x); run[1] = run[1] * dec + bfhi(loc[k].x); run[2] = run[2] * dec + bflo(loc[k].y); run[3] = run[3] * dec + bfhi(loc[k].y); }
    }
}

__device__ __forceinline__ void ret_gn(unsigned char* ws, int j, int b, bool weighted, bool ctxrows) {
    const int tid = ltid(), lane = tid & 63, wave = tid >> 6;
    const int gw = lbid() * NWAVES + wave, NGW = lgdim() * NWAVES;
    const bf16_t* O = ctxrows ? (const bf16_t*)(ws + WS_OCTX) : (const bf16_t*)(ws + WS_O) + (size_t)CTXL * 2048;
    bf16_t* G = (bf16_t*)(ws + WS_GZ) + (ctxrows ? (size_t)0 : ((size_t)b * TB + CTXL) * 2048);
    const int npos = ctxrows ? NB * CTXL : SEQ;
    const float* gn = (const float*)(ws + WS_SMALL) + SM_GN + j * RV;
    const int bid_ = gw / NWAVES, ng_ = NGW / NWAVES; const bool wgt = weighted && ng_ == 256;
    const int slot0 = wgt ? (bid_ < 24 ? 0 : (bid_ - 24)) : bid_, nslot = wgt ? (bid_ < 24 ? 0 : 1) : 1, tslots = wgt ? 232 : ng_;
    for (int sl = slot0; sl < slot0 + nslot; ++sl)
    for (int pos = sl * NWAVES + wave; pos < npos; pos += tslots * NWAVES) {
        const size_t grow = ctxrows ? (size_t)(pos >> 8) * TB + (pos & 255) : (size_t)pos;
        u32x4 ow[4], gwv[4];
#pragma unroll
        for (int h = 0; h < 4; ++h) { const size_t off = (size_t)pos * 2048 + h * 512 + lane * 8, goff = grow * 2048 + h * 512 + lane * 8; ow[h] = *(const u32x4*)(O + off); gwv[h] = *(const u32x4*)(G + goff); }
#pragma unroll
        for (int h = 0; h < 4; ++h) {
            const size_t off = grow * 2048 + h * 512 + lane * 8;
            const f32x4 w0 = *(const f32x4*)(gn + h * 512 + lane * 8), w1 = *(const f32x4*)(gn + h * 512 + lane * 8 + 4);
            float ov[8], gv[8]; unpack8(ow[h], ov); unpack8(gwv[h], gv);
            float sacc = 0.f;
#pragma unroll
            for (int q = 0; q < 8; ++q) sacc += ov[q];
            const float mu = wave_sum(sacc) * (1.f / 512.f); float s2 = 0.f;
#pragma unroll
            for (int q = 0; q < 8; ++q) { ov[q] -= mu; s2 += ov[q] * ov[q]; }
            const float rstd = __builtin_amdgcn_rsqf(wave_sum(s2) * (1.f / 512.f) + EPS);
            const float wv[8] = {w0.x, w0.y, w0.z, w0.w, w1.x, w1.y, w1.z, w1.w};
            float z[8];
#pragma unroll
            for (int q = 0; q < 8; ++q) z[q] = ov[q] * rstd * wv[q] * (gv[q] * sigm(gv[q]));
            store8(G + off, z);
        }
    }
}

__device__ __forceinline__ void lru_conv(unsigned char* ws, int j) {
    const bf16_t* XR = (const bf16_t*)(ws + WS_XR); bf16_t* XC = (bf16_t*)(ws + WS_XC);
    const float* cw = (const float*)(ws + WS_SMALL) + SM_CW + (size_t)j * 4 * LW; const float* cb = (const float*)(ws + WS_SMALL) + SM_CB + j * LW;
    const int NGT = lgdim() * NTHR; const int gt0 = lbid() * NTHR + ltid();
    for (int idx = gt0; idx < (MROWS / 8) * 160; idx += NGT) {
        const int cgp = idx % 160, rb = idx / 160, row0 = rb * 8, ch0 = cgp * 8;
        const int b = row0 / TB, pos0 = row0 - b * TB; const int s0 = pos0 < CTXL ? 0 : CTXL, e0 = pos0 < CTXL ? CTXL : TB;
        float w[4][8], bias[8];
#pragma unroll
        for (int t = 0; t < 4; ++t) { const f32x4 a = *(const f32x4*)(cw + t * LW + ch0), c = *(const f32x4*)(cw + t * LW + ch0 + 4);
            w[t][0] = a.x; w[t][1] = a.y; w[t][2] = a.z; w[t][3] = a.w; w[t][4] = c.x; w[t][5] = c.y; w[t][6] = c.z; w[t][7] = c.w; }
        { const f32x4 a = *(const f32x4*)(cb + ch0), c = *(const f32x4*)(cb + ch0 + 4); bias[0] = a.x; bias[1] = a.y; bias[2] = a.z; bias[3] = a.w; bias[4] = c.x; bias[5] = c.y; bias[6] = c.z; bias[7] = c.w; }
        u32x4 xin[11];
#pragma unroll
        for (int k = 0; k < 11; ++k) { const int pp = pos0 - 2 + k; const bool ok = pp >= s0 && pp < e0;
            xin[k] = ok ? *(const u32x4*)(XR + (size_t)(row0 - 2 + k) * LW + ch0) : (u32x4){0u, 0u, 0u, 0u}; }
#pragma unroll
        for (int r = 0; r < 8; ++r) {
            float o[8], t0[8], t1[8], t2[8], t3[8];
            unpack8(xin[r], t0); unpack8(xin[r + 1], t1); unpack8(xin[r + 2], t2); unpack8(xin[r + 3], t3);
#pragma unroll
            for (int q = 0; q < 8; ++q) o[q] = bias[q] + t0[q] * w[0][q] + t1[q] * w[1][q] + t2[q] * w[2][q] + t3[q] * w[3][q];
            store8(XC + (size_t)(row0 + r) * LW + ch0, o);
        }
    }
}

__device__ __forceinline__ void lru_p1(unsigned char* ws) {
    const unsigned* AU = (const unsigned*)(ws + WS_AU); f32x2* agg = (f32x2*)(ws + WS_AGG);
    const int NGT = lgdim() * NTHR; const int gt0 = lbid() * NTHR + ltid();
    for (int idx = gt0; idx < 2 * NSEG * LW; idx += NGT) {
        const int q_ = __builtin_amdgcn_readfirstlane(idx / LW), ch = idx - q_ * LW, sg = q_ % NSEG, bl = q_ / NSEG;
        const unsigned* p = AU + ((size_t)(bl * TB + sg * 32) * 2) * LW + ch;
        unsigned w0[32], w1[32];
#pragma unroll
        for (int t = 0; t < 32; ++t) { w0[t] = p[(size_t)(2 * t) * LW]; w1[t] = p[(size_t)(2 * t + 1) * LW]; }
        float sl = 1.f, hh = 0.f;
#pragma unroll
        for (int t = 0; t < 32; ++t) { const float a = 1.f - bflo(w0[t]); sl *= a; hh = a * hh + bfhi(w0[t]); }
        agg[((size_t)(bl * 2 + 0) * NSEG + sg) * LW + ch] = (f32x2){sl, hh};
        sl = 1.f; hh = 0.f;
#pragma unroll
        for (int t = 31; t >= 0; --t) { const float a = 1.f - bflo(w1[t]); sl *= a; hh = a * hh + bfhi(w1[t]); }
        agg[((size_t)(bl * 2 + 1) * NSEG + sg) * LW + ch] = (f32x2){sl, hh};
    }
}
__device__ __forceinline__ void lru_p2(unsigned char* ws, LAS unsigned char* lds) {
    const f32x2* agg = (const f32x2*)(ws + WS_AGG); float* carry = (float*)(ws + WS_CARRY);
    LAS f32x2* gl = (LAS f32x2*)lds;
    const int tid = ltid(), bid = lbid(), ng = lgdim();
    const int g = tid >> 6, cl = tid & 63;
    for (int task = bid; task < 4 * 20; task += ng) {
        const int bd = task / 20, ch = (task % 20) * 64 + cl, dir = bd & 1;
        const f32x2* ap = agg + (size_t)bd * NSEG * LW + ch; float* cp = carry + (size_t)bd * NSEG * LW + ch;
        f32x2 av[33];
#pragma unroll
        for (int k = 0; k < 33; ++k) { const int s = g * 33 + k, sg = dir == 0 ? s : (s < 8 ? 7 - s : 271 - s); av[k] = ap[(size_t)sg * LW]; }
        float A = 1.f, H = 0.f;
#pragma unroll
        for (int k = 0; k < 33; ++k) { H = av[k].x * H + av[k].y; A *= av[k].x; }
        __syncthreads();
        gl[g * 64 + cl] = (f32x2){A, H};
        __syncthreads();
        float run = 0.f;
        for (int gg = 0; gg < g; ++gg) { const f32x2 t = gl[gg * 64 + cl]; run = t.x * run + t.y; }
#pragma unroll
        for (int k = 0; k < 33; ++k) { const int s = g * 33 + k, sg = dir == 0 ? s : (s < 8 ? 7 - s : 271 - s); cp[(size_t)sg * LW] = run; run = av[k].x * run + av[k].y; }
    }
    __syncthreads();
}
__device__ __forceinline__ void lru_p3(unsigned char* ws, int hf) {
    const unsigned* AU = (const unsigned*)(ws + WS_AU); const float* carry = (const float*)(ws + WS_CARRY);
    bf16_t* GL = (bf16_t*)(ws + WS_GZ) + (size_t)hf * 2 * TB * LW;
    const int NGT = lgdim() * NTHR; const int gt0 = lbid() * NTHR + ltid();
    for (int idx = gt0; idx < 2 * NSEG * LW; idx += NGT) {
        const int q_ = __builtin_amdgcn_readfirstlane(idx / LW), ch = idx - q_ * LW, sg = q_ % NSEG, bl = q_ / NSEG;
        const size_t lrow0 = (size_t)bl * TB + sg * 32;
        const unsigned* p = AU + (lrow0 * 2) * LW + ch;
        unsigned w0[32], w1[32];
#pragma unroll
        for (int t = 0; t < 32; ++t) { w0[t] = p[(size_t)(2 * t) * LW]; w1[t] = p[(size_t)(2 * t + 1) * LW]; }
        float hcur = carry[((size_t)(bl * 2 + 0) * NSEG + sg) * LW + ch];
        float hb = carry[((size_t)(bl * 2 + 1) * NSEG + sg) * LW + ch];
        bf16_t* gp = GL + lrow0 * LW + ch;
        bf16_t gvv[32];
#pragma unroll
        for (int t = 0; t < 32; ++t) gvv[t] = gp[(size_t)t * LW];
        float hfv[32];
#pragma unroll
        for (int t = 0; t < 32; ++t) { hcur = (1.f - bflo(w0[t])) * hcur + bfhi(w0[t]); hfv[t] = hcur; }
#pragma unroll
        for (int t = 31; t >= 0; --t) { hb = (1.f - bflo(w1[t])) * hb + bfhi(w1[t]);
            const float g = bf1(gvv[t]); const float z = (hfv[t] + hb) * (g * sigm(g));
            gp[(size_t)t * LW] = (bf16_t)(pk2(z, 0.f) & 0xffffu); }
    }
}

#define XB_TMO      128
#define XB_XCNT(j)  (256  + 64 * (j))
#define XB_XSUB(j)  (1280 + 64 * (j))
#define XB_XGEN(j)  (2304 + 64 * (j))
#define XB_TOP      3328
#define XB_TOPGEN   3392
#define XCD_BAR_WORDS 3456
#define XB_SPIN_CAP (1u << 18)
__device__ __forceinline__ unsigned xb_ld(unsigned* p)              { return __hip_atomic_load(p, __ATOMIC_RELAXED, __HIP_MEMORY_SCOPE_AGENT); }
__device__ __forceinline__ unsigned xb_add(unsigned* p, unsigned v) { return __hip_atomic_fetch_add(p, v, __ATOMIC_RELAXED, __HIP_MEMORY_SCOPE_AGENT); }
__device__ __forceinline__ unsigned xb_xcc_id() { return (unsigned)__builtin_amdgcn_s_getreg((3 << 11) | 20) & 0xFu; }
#define XB_SPIN(cond, bar) do { unsigned _sp = 0; while (cond) { __builtin_amdgcn_s_sleep(1); \
    if ((++_sp & 255u) == 0u) { if (xb_ld(&(bar)[XB_TMO])) break; if (_sp > XB_SPIN_CAP) { atomicAdd(&(bar)[XB_TMO], 1u); break; } } } } while (0)
struct XcdBarrier { unsigned* bar; unsigned x; volatile LAS unsigned* st; };
__device__ __forceinline__ XcdBarrier xcd_barrier_post(unsigned* bar, volatile LAS unsigned* st) {
    XcdBarrier b; b.bar = bar; b.x = xb_xcc_id(); b.st = st;
    if (threadIdx.x == 0) (void)xb_add(&bar[XB_XCNT(b.x)], 1u);
    return b;
}
__device__ __forceinline__ void xcd_barrier_complete(unsigned* bar, unsigned x, unsigned& nloc, unsigned& nx) {
    const unsigned G = gridDim.x * gridDim.y * gridDim.z;
    unsigned sum, cnt, mine, sp = 0u;
    for (;;) {
        sum = 0u; cnt = 0u; mine = 0u;
#pragma unroll
        for (unsigned j = 0; j < 16; ++j) { const unsigned c = xb_ld(&bar[XB_XCNT(j)]); sum += c; cnt += (c > 0u) ? 1u : 0u; mine = (j == x) ? c : mine; }
        if (sum == G) break;
        __builtin_amdgcn_s_sleep(1);
        if ((++sp & 255u) == 0u) { if (xb_ld(&bar[XB_TMO])) break; if (sp > XB_SPIN_CAP) { atomicAdd(&bar[XB_TMO], 1u); break; } }
    }
    nloc = mine > 0u ? mine : 1u; nx = cnt > 0u ? cnt : 1u;
}
__device__ __forceinline__ void xcd_barrier(const XcdBarrier& b) {
    asm volatile("s_waitcnt vmcnt(0)" ::: "memory");
    __syncthreads();
    if (threadIdx.x == 0) {
        unsigned* bar = b.bar;
        __builtin_amdgcn_s_waitcnt(0);
        unsigned nloc = b.st[0], nx = b.st[1];
        if (nloc == 0u) { xcd_barrier_complete(bar, b.x, nloc, nx); b.st[0] = nloc; b.st[1] = nx; }
        const unsigned old = xb_add(&bar[XB_XSUB(b.x)], 1u);
        const unsigned gen = old / nloc;
        if (old + 1u == (gen + 1u) * nloc) {
            __builtin_amdgcn_fence(__ATOMIC_RELEASE, "agent");
            asm volatile("s_waitcnt vmcnt(0)" ::: "memory");
            const unsigned og = xb_add(&bar[XB_TOP], 1u);
            const unsigned tg = og / nx;
            if (og + 1u == (tg + 1u) * nx) xb_add(&bar[XB_TOPGEN], 1u);
            else XB_SPIN(xb_ld(&bar[XB_TOPGEN]) == tg, bar);
            __builtin_amdgcn_fence(__ATOMIC_ACQUIRE, "agent");
            xb_add(&bar[XB_XGEN(b.x)], 1u);
            asm volatile("s_waitcnt vmcnt(0)" ::: "memory");
        } else {
            XB_SPIN(xb_ld(&bar[XB_XGEN(b.x)]) == gen, bar);
            __builtin_amdgcn_fence(__ATOMIC_ACQUIRE, "agent");
            asm volatile("s_waitcnt vmcnt(0)" ::: "memory");
        }
    }
    __syncthreads();
}

#ifndef PROBE_SYNC
#define PROBE_SYNC 0
#endif
#ifndef GEMM_REP
#define GEMM_REP 1
#endif
#ifndef ELT_REP
#define ELT_REP 1
#endif
#ifndef REP_A
#define REP_A 1
#endif
#ifndef REP_B
#define REP_B 1
#endif
#ifndef REP_C
#define REP_C 1
#endif
#define REPA _Pragma("unroll 1") for (int rep_ = 0; rep_ < GEMM_REP * REP_A; ++rep_)
#define REPB _Pragma("unroll 1") for (int rep_ = 0; rep_ < GEMM_REP * REP_B; ++rep_)
#define REPC _Pragma("unroll 1") for (int rep_ = 0; rep_ < GEMM_REP * REP_C; ++rep_)
#define REPG _Pragma("unroll 1") for (int rep_ = 0; rep_ < GEMM_REP; ++rep_)
#define REPE _Pragma("unroll 1") for (int rep_ = 0; rep_ < ELT_REP; ++rep_)
__global__ __launch_bounds__(512, 2) void fwd_megakernel(Params P) {
    extern __shared__ __attribute__((aligned(16))) unsigned char shm[];
    LAS unsigned char* lds = (LAS unsigned char*)shm;
    cg::grid_group grid = cg::this_grid();
    if (threadIdx.x == 0) { *(volatile LAS unsigned*)(lds + 131072) = 0u; *(volatile LAS unsigned*)(lds + 131076) = 0u; }
    __syncthreads();
    (void)xcd_barrier_post((unsigned*)(P.ws + WS_BAR), (volatile LAS unsigned*)(lds + 131072));
#define SYNC() do { XcdBarrier xb_; xb_.bar = (unsigned*)(P.ws + WS_BAR); xb_.x = xb_xcc_id(); xb_.st = (volatile LAS unsigned*)(lds + 131072); xcd_barrier(xb_); if (PROBE_SYNC) xcd_barrier(xb_); } while (0)
#define WSL() size_t zz_ = 0; asm volatile("" : "+s"(zz_)); unsigned char* ws = P.ws + zz_; const int G = lgdim(), c = lbid(); (void)G; (void)c

    phase0(P, lds);
    if (gridDim.x > 65536u) grid.sync();
    SYNC();
    { WSL(); post_phase(P.x, P.ctx, P.out, ws, -1, lds); }
    SYNC();
#pragma unroll 1
    for (int layer = 0; layer < 4; ++layer) {
        const int j = layer >> 1;
        if ((layer & 1) == 0) {
#pragma unroll 1
            for (int b = 0; b < NB; ++b) {
                {
                    WSL();
                    SchedRetIn S{G, c, ws, j, b};
                    EpiRetIn E{ws, j, b};
                    REPA gemm_phase(lds, 1024, 1024, 1024, S, E);
                    if (b > 0) ret_gn(ws, j, b - 1, true, false);
                }
                SYNC();
                {
                    WSL();
                    SchedLoc S2{G, c, ws};
                    EpiLoc E2{ws};
                    REPB gemm_phase(lds, 256, 768, 256, S2, E2);
                }
                SYNC();
                {
                    WSL();
                    SchedS S{G, c, ws};
                    EpiS E{ws, j, b};
                    REPB gemm_phase(lds, 256, 768, 1024, S, E);
                    ret_scan(ws, j);
                }
                SYNC();
                {
                    WSL();
                    SchedO S{G, c, ws, 0};
                    EpiO E{ws};
                    REPB gemm_phase(lds, 768, 768, 768, S, E);
                    if (b == NB - 1) {
                        SchedO Sc{G, (c + 32) % G, ws, 1};
                        REPB gemm_phase(lds, 256, 256, 256, Sc, E);
                    }
                }
                SYNC();
            }
            { WSL(); ret_gn(ws, j, NB - 1, false, false); ret_gn(ws, j, 0, false, true); }
            SYNC();
            {
                WSL();
                SchedPlain S{G, c, 4, RV, ws, WS_GZ, WS_WROUT + (size_t)j * 1024 * RV * 2, 0};
                EpiY E{ws};
                REPG gemm_phase(lds, RV, RV, RV, S, E);
            }
            SYNC();
        } else {
            {
                WSL();
                SchedPlain S{G, c, 10, 1024, ws, WS_HN, WS_WLIN + (size_t)j * 2560 * 1024 * 2, 0};
                EpiLruIn E{ws};
                REPG gemm_phase(lds, 1024, 1024, 1024, S, E);
            }
            SYNC();
            { WSL(); REPE lru_conv(ws, j); }
            SYNC();
#pragma unroll 1
            for (int hf = 0; hf < 2; ++hf) {
                {
                    WSL();
                    SchedGate S{G, c, ws, j, hf};
                    EpiGate E{ws, j, hf};
                    REPC gemm_phase(lds, 128, LW, 128, S, E);
                }
                SYNC();
                { WSL(); REPE lru_p1(ws); }
                SYNC();
                { WSL(); REPE lru_p2(ws, lds); }
                SYNC();
                { WSL(); lru_p3(ws, hf); }
                SYNC();
            }
            {
                WSL();
                SchedPlain S{G, c, 4, LW, ws, WS_GZ, WS_WLOUT + (size_t)j * 1024 * LW * 2, layer == 3 ? 1 : 0};
                EpiY E{ws};
                REPG gemm_phase(lds, LW, LW, LW, S, E);
            }
            SYNC();
        }
        { WSL(); post_phase(P.x, P.ctx, P.out, ws, layer, lds); }
        if (layer < 3) SYNC();
    }
}

extern "C" void kernel_launch(void* const* d_in, const int* in_sizes, int n_in, void* d_out, int out_size, void* d_ws, size_t ws_size, hipStream_t stream) {
    static int grid_blocks = 0;
    if (grid_blocks == 0) {
        if (n_in != 21 || out_size != NB * SEQ * DM || ws_size < WS_END) { fprintf(stderr, "kernel_launch: unexpected shapes (n_in %d, out %d, ws %zu < %zu)\n", n_in, out_size, ws_size, (size_t)WS_END); grid_blocks = -1; return; }
        int dev = 0, cus = 0, per_cu = 0;
        hipGetDevice(&dev);
        hipDeviceGetAttribute(&cus, hipDeviceAttributeMultiprocessorCount, dev);
        if (hipFuncSetAttribute((const void*)fwd_megakernel, hipFuncAttributeMaxDynamicSharedMemorySize, LDS_BYTES) != hipSuccess) { fprintf(stderr, "kernel_launch: hipFuncSetAttribute failed\n"); }
        if (hipOccupancyMaxActiveBlocksPerMultiprocessor(&per_cu, (const void*)fwd_megakernel, NTHR, LDS_BYTES) != hipSuccess || per_cu < 1) per_cu = 1;
        (void)hipGetLastError();
        grid_blocks = cus * 1;
        if (grid_blocks <= 0) grid_blocks = 256;
    }
    if (grid_blocks < 0) return;
    Params p{};
    p.x = (const float*)d_in[0]; p.c = (const float*)d_in[1]; p.ctx = (const float*)d_in[2]; p.c_ctx = (const float*)d_in[3];
    p.mod_w = (const float*)d_in[4]; p.mod_b = (const float*)d_in[5]; p.norm_pre = (const float*)d_in[6]; p.norm_post = (const float*)d_in[7];
    p.ret_w_in = (const float*)d_in[8]; p.ret_log_decay = (const float*)d_in[9]; p.ret_gn = (const float*)d_in[10]; p.ret_w_out = (const float*)d_in[11];
    p.lru_w_in = (const float*)d_in[12]; p.lru_conv_w = (const float*)d_in[13]; p.lru_conv_b = (const float*)d_in[14];
    p.lru_w_a = (const float*)d_in[15]; p.lru_b_a = (const float*)d_in[16]; p.lru_w_x = (const float*)d_in[17]; p.lru_b_x = (const float*)d_in[18];
    p.lru_lambda = (const float*)d_in[19]; p.lru_w_out = (const float*)d_in[20];
    p.out = (float*)d_out; p.ws = (unsigned char*)d_ws;
    if (hipMemsetAsync((char*)d_ws + WS_BAR, 0, WS_BAR_BYTES, stream) != hipSuccess) fprintf(stderr, "kernel_launch: memset of barrier words failed\n");
    void* args[] = {&p};
    hipError_t e = hipLaunchCooperativeKernel((const void*)fwd_megakernel, dim3(grid_blocks), dim3(NTHR), args, LDS_BYTES, stream);
    if (e != hipSuccess) fprintf(stderr, "cooperative launch failed: %s (grid %d)\n", hipGetErrorString(e), grid_blocks);
}
```

```cpp
#include <hip/hip_runtime.h>
#include <hip/hip_cooperative_groups.h>
#include <cstdio>
#include <cstdint>
namespace cg = cooperative_groups;

#define LAS __attribute__((address_space(3)))
typedef unsigned short bf16_t;
typedef short bf16x8 __attribute__((ext_vector_type(8)));
typedef float f32x4 __attribute__((ext_vector_type(4)));
typedef float f32x2 __attribute__((ext_vector_type(2)));
typedef unsigned u32x4 __attribute__((ext_vector_type(4)));
typedef unsigned u32x2 __attribute__((ext_vector_type(2)));

constexpr int DM = 1024, NB = 4, SEQ = 8192, CTXL = 256, TB = SEQ + CTXL  , MROWS = NB * TB  , NCHK = TB / 256  ;
constexpr int RIN = 6144, RV = 2048, LW = 1280, NSEG = TB / 32  ;
constexpr float EPS = 1e-6f;
constexpr int NTHR = 512, NWAVES = 8;
constexpr int LDS_BYTES = 131072 + 256;

constexpr size_t al256(size_t x) { return (x + 255) & ~size_t(255); }
constexpr size_t WS_BAR = 0;
constexpr size_t WS_BAR_BYTES = 16384;
constexpr size_t WS_MOD = WS_BAR + WS_BAR_BYTES;
constexpr size_t WS_ROPE = al256(WS_MOD + 4 * 5 * 3072 * 4);
constexpr size_t WS_ROPET = WS_ROPE + 65536;
constexpr size_t WS_C8SP = WS_ROPET + 65536;
constexpr size_t WS_SMALL = al256(WS_C8SP + 2 * 2 * 1280 * 4);
constexpr int SM_NPRE = 0, SM_NPOST = 4096, SM_GN = 8192, SM_L2D = 12288, SM_CW = 12304, SM_CB = 22544, SM_BA = 25104, SM_BX = 30224, SM_END = 35344;
constexpr size_t WS_XCTX = al256(WS_SMALL + SM_END * 4);
constexpr size_t WS_WRIN = WS_XCTX + 1024ull * 1024 * 4;
constexpr size_t WS_WROUT = WS_WRIN + 2ull * 6144 * 1024 * 2;
constexpr size_t WS_WLIN = WS_WROUT + 2ull * 1024 * 2048 * 2;
constexpr size_t WS_WLG = WS_WLIN + 2ull * 2560 * 1024 * 2;
constexpr size_t WS_WLOUT = WS_WLG + 2ull * 10 * 512 * 128 * 2;
constexpr size_t WS_GZ = WS_WLOUT + 2ull * 1024 * 1280 * 2;
constexpr size_t WS_AGG = WS_GZ + 33792ull * 1280 * 2;
constexpr size_t WS_CARRY = WS_AGG + 2ull * 2 * 264 * 1280 * 8;
constexpr size_t WS_HN = WS_GZ + 33792ull * 2048 * 2;
constexpr size_t WS_R = WS_HN + 33792ull * 1024 * 2;
constexpr size_t WS_QN = WS_R;
constexpr size_t WS_KN = WS_QN + 8448ull * 1024 * 2;
constexpr size_t WS_KDT = WS_KN + 8448ull * 1024 * 2;
constexpr size_t WS_ACAT = WS_KDT + 2ull * 1024 * 8448 * 2;
constexpr size_t WS_BCAT = WS_ACAT + 4ull * 8448 * 768 * 2;
constexpr size_t WS_O = WS_BCAT + 4ull * 33 * 512 * 768 * 2;
constexpr size_t WS_SCTX = WS_O + 8448ull * 2048 * 2;
constexpr size_t WS_VCTX = WS_SCTX + 4ull * 4 * 256 * 256 * 2;
constexpr size_t WS_OCTX = WS_VCTX + 4ull * 4 * 512 * 256 * 2;
constexpr size_t WS_END = WS_OCTX + 4ull * 256 * 2048 * 2;
constexpr size_t WS_XR = WS_R;
constexpr size_t WS_XC = WS_END - 33792ull * 1280 * 2;
constexpr size_t WS_AU = WS_HN;
constexpr size_t WS_Y = WS_R;
static_assert(WS_END <= 536870912ull, "workspace");
static_assert(WS_CARRY + 2ull * 2 * 264 * 1280 * 4 <= WS_HN, "agg/carry fit");
static_assert(WS_AU + 16896ull * 2 * 1280 * 4 <= WS_XC, "AU vs XC");
static_assert(WS_Y + 33792ull * 1024 * 4 <= WS_XC, "Y vs XC");

struct Params {
    const float *x, *c, *ctx, *c_ctx, *mod_w, *mod_b, *norm_pre, *norm_post;
    const float *ret_w_in, *ret_log_decay, *ret_gn, *ret_w_out;
    const float *lru_w_in, *lru_conv_w, *lru_conv_b, *lru_w_a, *lru_b_a, *lru_w_x, *lru_b_x, *lru_lambda, *lru_w_out;
    float* out; unsigned char* ws;
};

__device__ __forceinline__ unsigned pk2(float lo, float hi) { unsigned r; asm("v_cvt_pk_bf16_f32 %0, %1, %2" : "=v"(r) : "v"(lo), "v"(hi)); return r; }
__device__ __forceinline__ float bflo(unsigned u) { return __uint_as_float(u << 16); }
__device__ __forceinline__ float bfhi(unsigned u) { return __uint_as_float(u & 0xffff0000u); }
__device__ __forceinline__ float bf1(bf16_t b) { return __uint_as_float(((unsigned)b) << 16); }
__device__ __forceinline__ float ex2(float x) { return __builtin_amdgcn_exp2f(x); }
__device__ __forceinline__ float fexp(float x) { return __builtin_amdgcn_exp2f(x * 1.4426950408889634f); }
__device__ __forceinline__ float frcp(float x) { return __builtin_amdgcn_rcpf(x); }
__device__ __forceinline__ float sigm(float x) { return frcp(1.f + fexp(-x)); }
__device__ __forceinline__ int ltid() { int t = threadIdx.x; asm volatile("" : "+v"(t)); return t; }
__device__ __forceinline__ int lbid() { int t = blockIdx.x; asm volatile("" : "+s"(t)); return t; }
__device__ __forceinline__ int lgdim() { int t = gridDim.x; asm volatile("" : "+s"(t)); return t; }
template <int CTRL> __device__ __forceinline__ float dpp_f(float v) { return __builtin_bit_cast(float, __builtin_amdgcn_update_dpp(0, __builtin_bit_cast(int, v), CTRL, 0xf, 0xf, true)); }
__device__ __forceinline__ float lane_xor1(float v) { return dpp_f<0xB1>(v); }
__device__ __forceinline__ float wave_sum(float v) {
    v += dpp_f<0xB1>(v); v += dpp_f<0x4E>(v); v += dpp_f<0x141>(v); v += dpp_f<0x140>(v);
    const int vi = __builtin_bit_cast(int, v);
    const float s0 = __builtin_bit_cast(float, __builtin_amdgcn_readlane(vi, 0)), s1 = __builtin_bit_cast(float, __builtin_amdgcn_readlane(vi, 16));
    const float s2 = __builtin_bit_cast(float, __builtin_amdgcn_readlane(vi, 32)), s3 = __builtin_bit_cast(float, __builtin_amdgcn_readlane(vi, 48));
    return (s0 + s1) + (s2 + s3);
}
__device__ __forceinline__ void store8(bf16_t* p, const float (&v)[8]) {
    u32x4 o; o.x = pk2(v[0], v[1]); o.y = pk2(v[2], v[3]); o.z = pk2(v[4], v[5]); o.w = pk2(v[6], v[7]);
    *(u32x4*)p = o;
}
__device__ __forceinline__ void store8s(bf16_t* p, const float (&v)[8], float s) {
    u32x4 o; o.x = pk2(v[0] * s, v[1] * s); o.y = pk2(v[2] * s, v[3] * s); o.z = pk2(v[4] * s, v[5] * s); o.w = pk2(v[6] * s, v[7] * s);
    *(u32x4*)p = o;
}
__device__ __forceinline__ void unpack8(const u32x4 w, float (&v)[8]) {
    v[0] = bflo(w.x); v[1] = bfhi(w.x); v[2] = bflo(w.y); v[3] = bfhi(w.y); v[4] = bflo(w.z); v[5] = bfhi(w.z); v[6] = bflo(w.w); v[7] = bfhi(w.w);
}

constexpr int BM = 256, BK = 64, HALF = 128, HTB = HALF * BK * 2, NXCD = 8, WGM = 4;
__device__ __forceinline__ int lds_byte(int r, int c) { const int st = (r >> 4) * 2 + (c >> 5), rr = r & 15, cc = c & 31, ob = rr * 64 + cc * 2; return st * 1024 + (ob ^ (((ob >> 9) & 1) << 5)); }
__device__ __forceinline__ void stage_rc(int b, int& R, int& C) { const int st = b / 1024, sb = b % 1024, swz = sb ^ (((sb >> 9) & 1) << 5); R = (st >> 1) * 16 + swz / 64; C = (st & 1) * 32 + (swz % 64) / 2; }
__device__ __forceinline__ int perm32(int rho) { const int n = rho >> 4, i = rho & 15; return 8 * (i >> 2) + 4 * n + (i & 3); }

struct Unit { const char* a; const char* b; int t, i0, i1, i2; };

__device__ __forceinline__ void tile_order(int L, int nM, int nN, int& pm, int& pn) {
    const int nwg = nM * nN; int wgid = L;
    { const int q = nwg / NXCD, r = nwg % NXCD, xcd = wgid % NXCD, off = wgid / NXCD; wgid = (xcd < r ? xcd * (q + 1) : r * (q + 1) + (xcd - r) * q) + off; }
    const int nig = WGM * nN, gid = wgid / nig, fm = gid * WGM, gsz = (nM - fm) < WGM ? (nM - fm) : WGM;
    pm = fm + ((wgid % nig) % gsz); pn = (wgid % nig) / gsz;
}

#define ACC_T const f32x4 (&acc)[2][2][4][2]

template <class Epi, class Sched>
__device__ __forceinline__ void gemm_phase(LAS unsigned char* lds, const int K, const int lda, const int ldb, const Sched& S, const Epi& E) {
    const int tid = ltid(), wid = __builtin_amdgcn_readfirstlane(tid >> 6), lane = tid & 63, wr = wid >> 2, wc = wid & 3, fr = lane & 15, fq = lane >> 4;
    const int nt = K / BK;
    unsigned voffA[2], voffB[2];
#pragma unroll
    for (int i = 0; i < 2; ++i) { int R, C; stage_rc(tid * 16 + i * 8192, R, C); const int Rb = Epi::PERM ? ((R & ~31) + perm32(R & 31)) : R;
        voffA[i] = (unsigned)(R * lda + C) * 2u; voffB[i] = (unsigned)(Rb * ldb + C) * 2u; }
    const size_t kstep = (size_t)(BK * 2);
    const size_t hstepA = (size_t)HALF * lda * 2, hstepB = (size_t)HALF * ldb * 2;
    const unsigned ldsw = (unsigned)wid * 1024u;
    const int aoff = lds_byte(wr * 64 + fr, fq * 8), boff = lds_byte(wc * 32 + fr, fq * 8);
#define PG8_SA(b, h) (((b) * 2 + (h)) * HTB)
#define PG8_SB(b, h) ((4 + (b) * 2 + (h)) * HTB)
#define PG8_STAGE(bufoff, gbase, voff) do { _Pragma("unroll") for (int _i = 0; _i < 2; ++_i) \
        __builtin_amdgcn_global_load_lds((const unsigned*)((const char*)(gbase) + (voff)[_i]), (LAS unsigned*)(lds + (bufoff) + ldsw + _i * 8192), 16, 0, 0); } while (0)
#define PG8_LDA(dst, b, h) do { _Pragma("unroll") for (int m = 0; m < 4; ++m) _Pragma("unroll") for (int k = 0; k < 2; ++k) dst[m][k] = *(const LAS bf16x8*)(lds + PG8_SA(b, h) + aoff + m * 2048 + k * 1024); } while (0)
#define PG8_LDB(dst, b, h) do { _Pragma("unroll") for (int n = 0; n < 2; ++n) _Pragma("unroll") for (int k = 0; k < 2; ++k) dst[n][k] = *(const LAS bf16x8*)(lds + PG8_SB(b, h) + boff + n * 2048 + k * 1024); } while (0)
#define PG8_MMA(ai, bj, At, Bt) do { __builtin_amdgcn_s_setprio(1); _Pragma("unroll") for (int m = 0; m < 4; ++m) _Pragma("unroll") for (int n = 0; n < 2; ++n) _Pragma("unroll") for (int k = 0; k < 2; ++k) \
        acc[ai][bj][m][n] = __builtin_amdgcn_mfma_f32_16x16x32_bf16(Bt[n][k], At[m][k], acc[ai][bj][m][n], 0, 0, 0); __builtin_amdgcn_s_setprio(0); } while (0)
#define PG8_WAIT_V(n) asm volatile("s_waitcnt vmcnt(" #n ")" ::: "memory")
#define PG8_WAIT_L(n) asm volatile("s_waitcnt lgkmcnt(" #n ")" ::: "memory")
#define PG8_BAR __builtin_amdgcn_s_barrier()
#define PG8_SCHED __builtin_amdgcn_sched_barrier(0)
    Unit cur, nxt; int ui = 0;
    if (!S.next(0, cur)) return;
    f32x4 acc[2][2][4][2];
#pragma unroll
    for (int a = 0; a < 2; ++a)
#pragma unroll
        for (int b = 0; b < 2; ++b)
#pragma unroll
            for (int m = 0; m < 4; ++m)
#pragma unroll
                for (int n = 0; n < 2; ++n) acc[a][b][m][n] = (f32x4){0.f, 0.f, 0.f, 0.f};
    bf16x8 At[4][2], B0[2][2], B1[2][2];
    const char* cA = cur.a; const char* cB = cur.b;
    PG8_STAGE(PG8_SB(0, 0), cB, voffB); PG8_STAGE(PG8_SA(0, 0), cA, voffA); PG8_STAGE(PG8_SB(0, 1), cB + hstepB, voffB); PG8_STAGE(PG8_SA(0, 1), cA + hstepA, voffA);
    if (wr == 1) PG8_BAR;
    PG8_WAIT_V(4); PG8_BAR;
    PG8_STAGE(PG8_SB(1, 0), cB + kstep, voffB); PG8_STAGE(PG8_SA(1, 0), cA + kstep, voffA); PG8_STAGE(PG8_SB(1, 1), cB + hstepB + kstep, voffB);
    PG8_WAIT_V(6); PG8_BAR;
    for (;;) {
        const bool has_next = S.next(ui + 1, nxt);
        const char* nA = has_next ? nxt.a : cA; const char* nB = has_next ? nxt.b : cB;
        for (int t = 0; t < nt; t += 2) {
            const bool last = (t == nt - 2);
            const char* a1 = cA + (size_t)(t + 1) * kstep;
            const char* a2 = last ? nA : cA + (size_t)(t + 2) * kstep; const char* b2 = last ? nB : cB + (size_t)(t + 2) * kstep;
            const char* a3 = a2 + kstep; const char* b3 = b2 + kstep;
            PG8_LDB(B0, 0, 0); PG8_SCHED; PG8_LDA(At, 0, 0); PG8_STAGE(PG8_SA(1, 1), a1 + hstepA, voffA);
            PG8_WAIT_L(8); PG8_BAR; PG8_WAIT_L(0); PG8_MMA(0, 0, At, B0); PG8_BAR; PG8_SCHED;
            PG8_LDB(B1, 0, 1); PG8_STAGE(PG8_SB(0, 0), b2, voffB);
            PG8_BAR; PG8_WAIT_L(0); PG8_MMA(0, 1, At, B1); PG8_BAR;
            PG8_LDA(At, 0, 1); PG8_STAGE(PG8_SA(0, 0), a2, voffA);
            PG8_BAR; PG8_WAIT_L(0); PG8_MMA(1, 0, At, B0); PG8_BAR; PG8_SCHED;
            PG8_STAGE(PG8_SB(0, 1), b2 + hstepB, voffB);
            PG8_WAIT_V(6); PG8_BAR; PG8_MMA(1, 1, At, B1); PG8_BAR;
            PG8_LDB(B0, 1, 0); PG8_SCHED; PG8_LDA(At, 1, 0); PG8_STAGE(PG8_SA(0, 1), a2 + hstepA, voffA);
            PG8_WAIT_L(8); PG8_BAR; PG8_WAIT_L(0); PG8_MMA(0, 0, At, B0); PG8_BAR; PG8_SCHED;
            PG8_LDB(B1, 1, 1); PG8_STAGE(PG8_SB(1, 0), b3, voffB);
            PG8_BAR; PG8_WAIT_L(0); PG8_MMA(0, 1, At, B1); PG8_BAR;
            PG8_LDA(At, 1, 1); PG8_STAGE(PG8_SA(1, 0), a3, voffA);
            PG8_BAR; PG8_WAIT_L(0); PG8_MMA(1, 0, At, B0); PG8_BAR; PG8_SCHED;
            PG8_STAGE(PG8_SB(1, 1), b3 + hstepB, voffB);
            PG8_WAIT_V(6); PG8_BAR; PG8_MMA(1, 1, At, B1); PG8_BAR;
        }
        E(acc, cur, wr, wc, fr, fq);
        if (!has_next) break;
#pragma unroll
        for (int a = 0; a < 2; ++a)
#pragma unroll
            for (int b = 0; b < 2; ++b)
#pragma unroll
                for (int m = 0; m < 4; ++m)
#pragma unroll
                    for (int n = 0; n < 2; ++n) acc[a][b][m][n] = (f32x4){0.f, 0.f, 0.f, 0.f};
        cur = nxt; cA = nA; cB = nB; ++ui;
    }
    PG8_WAIT_V(0);
    if (wr == 0) PG8_BAR;
    PG8_BAR;
#undef PG8_SA
#undef PG8_SB
#undef PG8_STAGE
#undef PG8_LDA
#undef PG8_LDB
#undef PG8_MMA
#undef PG8_WAIT_V
#undef PG8_WAIT_L
#undef PG8_BAR
#undef PG8_SCHED
}

#define GET8(v, ai, bj, m) float v[8]; { const f32x4 _a = acc[ai][bj][m][0], _b = acc[ai][bj][m][1]; v[0] = _a.x; v[1] = _a.y; v[2] = _a.z; v[3] = _a.w; v[4] = _b.x; v[5] = _b.y; v[6] = _b.z; v[7] = _b.w; }
#define FOR_AI_M _Pragma("unroll") for (int ai = 0; ai < 2; ++ai) _Pragma("unroll") for (int m = 0; m < 4; ++m)
#define FOR_BJ _Pragma("unroll") for (int bj = 0; bj < 2; ++bj)

__device__ __forceinline__ float lg2dec(const float* ld, int j, int dir, int h) { return ld[j * 8 + dir * 4 + h]; }

__device__ __forceinline__ void rot2(float& e, float& o, float c, float s) { const float te = e, to = o; e = te * c - to * s; o = te * s + to * c; }

struct SchedRetIn {
    int G, c; unsigned char* ws; int j, b;
    __device__ __forceinline__ bool next(int i, Unit& u) const {
        const int L = i * G + c; if (L >= 792) return false;
        size_t z_ = 0; asm volatile("" : "+s"(z_)); unsigned char* w_ = ws + z_;
        const char* hn = (const char*)(w_ + WS_HN) + (size_t)b * TB * 1024 * 2; const char* w = (const char*)(w_ + WS_WRIN) + (size_t)j * RIN * 1024 * 2;
        if (L < 528) { int pm, pn; tile_order(L, 33, 16, pm, pn); u.t = 0; u.i0 = pm; u.i1 = pn;
            u.a = hn + (size_t)pm * 256 * 1024 * 2; u.b = w + (size_t)((pn < 8 ? pn : pn + 8) * 256) * 1024 * 2; }
        else { int pm, pn; tile_order(L - 528, 8, 33, pm, pn); pm += 4; u.t = 1; u.i0 = pm; u.i1 = pn;
            u.a = w + (size_t)(1024 + pm * 256) * 1024 * 2; u.b = hn + (size_t)pn * 256 * 1024 * 2; }
        u.i2 = 0; return true;
    }
};
struct EpiRetIn {
    static constexpr bool PERM = true;
    unsigned char* ws; int j, b;
    __device__ __forceinline__ void operator()(ACC_T, const Unit& u, int wr_, int wc_, int fr, int fq) const {
        int wr = wr_, wc = wc_; asm volatile("" : "+v"(wr), "+v"(wc));
        size_t z_ = 0; asm volatile("" : "+s"(z_)); unsigned char* w_ = ws + z_;
        bf16_t* Qn = (bf16_t*)(w_ + WS_QN); bf16_t* Kn = (bf16_t*)(w_ + WS_KN); bf16_t* KdT = (bf16_t*)(w_ + WS_KDT); bf16_t* Acat = (bf16_t*)(w_ + WS_ACAT); bf16_t* Bcat = (bf16_t*)(w_ + WS_BCAT);
        bf16_t* G = (bf16_t*)(w_ + WS_GZ) + (size_t)b * TB * 2048;
        const f32x2* rope = (const f32x2*)(w_ + WS_ROPE); const f32x2* ropeT = (const f32x2*)(w_ + WS_ROPET); const float* ld = (const float*)(w_ + WS_SMALL) + SM_L2D;
        const int c8 = 32 * wc + 8 * fq;
        if (u.t == 0) {
            const int pm = u.i0, pn = u.i1;
            if (pn >= 8) {
                bf16_t* gp = G + (size_t)(pm * 256) * 2048 + (pn - 8) * 256 + c8;
                FOR_AI_M { const int r = 128 * ai + 64 * wr + 16 * m + fr;
                    FOR_BJ { GET8(v, ai, bj, m); store8(gp + (size_t)r * 2048 + 128 * bj, v); __builtin_amdgcn_sched_barrier(0); } }
            } else {
                const int h = pn & 3; const bool isq = pn < 4, lat = pm > 0;
                const float lf = lg2dec(ld, j, 0, h), lb = lg2dec(ld, j, 1, h);
                const int li = fr & 7, lg8 = fr >> 3;
                float ftq[8], btq[8];
                if (!isq) {
#pragma unroll
                    for (int q = 0; q < 8; ++q) { ftq[q] = ex2(-lf * (float)q); btq[q] = ex2(lb * (float)q); }
                }
                FOR_AI_M { const int r = 128 * ai + 64 * wr + 16 * m + fr, pos = pm * 256 + r, t = pos - 256, rg = t >> 6, cgc = t & 63;
                    const float df = ex2(lf * (float)(r + 1)), db = ex2(lb * (float)(256 - r));
                    FOR_BJ { GET8(v, ai, bj, m);
                        if (lat) { const int p = bj ? cgc : rg; const f32x4* cs = (const f32x4*)(rope + p * 64 + (c8 >> 1)); const f32x4 c01 = cs[0], c23 = cs[1];
                            rot2(v[0], v[1], c01.x, c01.y); rot2(v[2], v[3], c01.z, c01.w); rot2(v[4], v[5], c23.x, c23.y); rot2(v[6], v[7], c23.z, c23.w); }
                        const int d0 = 128 * bj + c8;
                        if (isq) {
                            bf16_t* ap = Acat + ((size_t)h * TB + pos) * 768 + d0; store8s(ap + 256, v, df); store8s(ap + 512, v, db); }
                        else { store8s(Kn + (size_t)pos * 1024 + h * 256 + d0, v, 0.0625f);
#define XCH(A, B, BIT, FA, FB) { const float pa_ = FA, pb_ = FB; if (li & BIT) A = pb_; else B = pa_; }
                            XCH(v[0], v[1], 1, dpp_f<0xB1>(v[0]), dpp_f<0xB1>(v[1])) XCH(v[2], v[3], 1, dpp_f<0xB1>(v[2]), dpp_f<0xB1>(v[3]))
                            XCH(v[4], v[5], 1, dpp_f<0xB1>(v[4]), dpp_f<0xB1>(v[5])) XCH(v[6], v[7], 1, dpp_f<0xB1>(v[6]), dpp_f<0xB1>(v[7]))
                            XCH(v[0], v[2], 2, dpp_f<0x4E>(v[0]), dpp_f<0x4E>(v[2])) XCH(v[1], v[3], 2, dpp_f<0x4E>(v[1]), dpp_f<0x4E>(v[3]))
                            XCH(v[4], v[6], 2, dpp_f<0x4E>(v[4]), dpp_f<0x4E>(v[6])) XCH(v[5], v[7], 2, dpp_f<0x4E>(v[5]), dpp_f<0x4E>(v[7]))
#define X4(x) dpp_f<0x1B>(dpp_f<0x141>(x))
                            XCH(v[0], v[4], 4, X4(v[0]), X4(v[4])) XCH(v[1], v[5], 4, X4(v[1]), X4(v[5]))
                            XCH(v[2], v[6], 4, X4(v[2]), X4(v[6])) XCH(v[3], v[7], 4, X4(v[3]), X4(v[7]))
#undef X4
#undef XCH
                            const int rt0 = 128 * ai + 64 * wr + 16 * m + 8 * lg8;
                            const float fb = ex2(lf * (float)(255 - rt0)) * 0.0625f, bbs = ex2(lb * (float)rt0) * 0.0625f;
                            float vf[8], vb[8];
#pragma unroll
                            for (int q = 0; q < 8; ++q) { vf[q] = v[q] * (fb * ftq[q]); vb[q] = v[q] * (bbs * btq[q]); }
                            store8(KdT + ((size_t)(h * NCHK + pm) * 256 + d0 + li) * 256 + rt0, vf); store8(KdT + ((size_t)((4 + h) * NCHK + pm) * 256 + d0 + li) * 256 + rt0, vb);
                        }
                        __builtin_amdgcn_sched_barrier(0);
                    } }
            }
        } else {
            const int pm = u.i0, pn = u.i1;
            if (pm >= 4) {
                const int h = (pm - 4) >> 1, e0 = ((pm - 4) & 1) * 256;
                bf16_t* bp = Bcat + ((size_t)(h * NCHK + pn) * 512 + e0) * 768 + c8;
                bf16_t* vp = (bf16_t*)(w_ + WS_VCTX) + ((size_t)(b * 4 + h) * 512 + e0) * 256 + c8;
                FOR_AI_M { const int r = 128 * ai + 64 * wr + 16 * m + fr;
                    FOR_BJ { GET8(v, ai, bj, m); store8(bp + (size_t)r * 768 + 128 * bj, v); if (pn == 0) store8(vp + (size_t)r * 256 + 128 * bj, v); __builtin_amdgcn_sched_barrier(0); } }
            }
        }
    }
};

struct SchedS {
    int G, c; unsigned char* ws;
    __device__ __forceinline__ bool next(int i, Unit& u) const {
        const int L = i * G + c; if (L >= 132) return false;
        size_t z_ = 0; asm volatile("" : "+s"(z_)); unsigned char* w_ = ws + z_;
        const char* kn = (const char*)(w_ + WS_KN);
        const int h = L & 3, ch = L >> 2; const size_t off = ((size_t)ch * 256 * 1024 + h * 256) * 2;
        u.a = (const char*)(w_ + WS_ACAT) + (((size_t)h * TB + ch * 256) * 768 + 256) * 2;
        u.b = kn + off; u.t = 0; u.i0 = h; u.i1 = ch; u.i2 = 0; return true;
    }
};
struct EpiS {
    static constexpr bool PERM = true;
    unsigned char* ws; int j, b;
    __device__ __forceinline__ void operator()(ACC_T, const Unit& u, int wr_, int wc_, int fr, int fq) const {
        int wr = wr_, wc = wc_; asm volatile("" : "+v"(wr), "+v"(wc));
        size_t z_ = 0; asm volatile("" : "+s"(z_)); unsigned char* w_ = ws + z_;
        bf16_t* Acat = (bf16_t*)(w_ + WS_ACAT); const float* ld = (const float*)(w_ + WS_SMALL) + SM_L2D;
        const int h = u.i0, ch = u.i1, c8 = 32 * wc + 8 * fq;
        const float lf = lg2dec(ld, j, 0, h), lb = lg2dec(ld, j, 1, h);
        const int rs_ = ch == 0 ? 256 : 768;
        bf16_t* ap = (ch == 0 ? (bf16_t*)(w_ + WS_SCTX) + (size_t)(b * 4 + h) * 65536 : Acat + ((size_t)h * TB + ch * 256) * 768) + c8;
        float cfm[2][8], cbm[2][8];
#pragma unroll
        for (int bj = 0; bj < 2; ++bj)
#pragma unroll
            for (int q = 0; q < 8; ++q) { const float mm = (float)(128 * bj + c8 + q); cfm[bj][q] = ex2(-lf * (mm + 1.f)); cbm[bj][q] = ex2(lb * mm); }
        FOR_AI_M { const int n = 128 * ai + 64 * wr + 16 * m + fr; const float nf = (float)n;
            const float rbn = ex2(-(lf + lb) * nf - lf), dgn = 2.f * ex2(-lf * (nf + 1.f));
            FOR_BJ { GET8(v, ai, bj, m); const int m0 = 128 * bj + c8;
#pragma unroll
                for (int q = 0; q < 8; ++q) { const int dl = n - (m0 + q); const float fac = dl > 0 ? cfm[bj][q] : (dl < 0 ? cbm[bj][q] * rbn : dgn); v[q] *= fac; }
                store8(ap + (size_t)n * rs_ + 128 * bj, v); __builtin_amdgcn_sched_barrier(0); } }
    }
};

struct SchedLoc {
    int G, c; unsigned char* ws;
    __device__ __forceinline__ bool next(int i, Unit& u) const {
        const int L = i * G + c; if (L >= 512) return false;
        size_t z_ = 0; asm volatile("" : "+s"(z_)); unsigned char* w_ = ws + z_;
        const char* bcat = (const char*)(w_ + WS_BCAT); const char* kdt = (const char*)(w_ + WS_KDT);
        const int eh = L & 1, dir = (L >> 1) & 1, h = (L >> 2) & 3, k = L >> 4, ch = (dir == 0 || k == 0) ? k : k + 1;
        u.a = bcat + ((size_t)(h * NCHK + ch) * 512 + eh * 256) * 768 * 2;
        u.b = kdt + (size_t)((dir * 4 + h) * NCHK + ch) * 65536 * 2;
        u.t = eh; u.i0 = h; u.i1 = ch; u.i2 = dir; return true;
    }
};
struct EpiLoc {
    static constexpr bool PERM = true;
    unsigned char* ws;
    __device__ __forceinline__ void operator()(ACC_T, const Unit& u, int wr_, int wc_, int fr, int fq) const {
        int wr = wr_, wc = wc_; asm volatile("" : "+v"(wr), "+v"(wc));
        size_t z_ = 0; asm volatile("" : "+s"(z_)); unsigned char* w_ = ws + z_;
        bf16_t* Bcat = (bf16_t*)(w_ + WS_BCAT);
        const int c8 = 32 * wc + 8 * fq;
        bf16_t* bp = Bcat + ((size_t)(u.i0 * NCHK + u.i1) * 512 + u.t * 256) * 768 + 256 + u.i2 * 256 + c8;
        FOR_AI_M { const int r = 128 * ai + 64 * wr + 16 * m + fr;
            FOR_BJ { GET8(v, ai, bj, m); store8(bp + (size_t)r * 768 + 128 * bj, v); __builtin_amdgcn_sched_barrier(0); } }
    }
};

struct SchedO {
    int G, c; unsigned char* ws; int small;
    __device__ __forceinline__ bool next(int i, Unit& u) const {
        const int L = i * G + c; if (L >= (small ? 32 : 256)) return false;
        size_t z_ = 0; asm volatile("" : "+s"(z_)); unsigned char* w_ = ws + z_;
        const char* acat = (const char*)(w_ + WS_ACAT); const char* bcat = (const char*)(w_ + WS_BCAT);
        const int nh = L & 1, h = (L >> 1) & 3, ch = small ? 0 : 1 + (L >> 3), bb = L >> 3;
        if (small) { u.a = (const char*)(w_ + WS_SCTX) + (size_t)(bb * 4 + h) * 65536 * 2; u.b = (const char*)(w_ + WS_VCTX) + ((size_t)(bb * 4 + h) * 512 + nh * 256) * 256 * 2; u.t = nh; u.i0 = h; u.i1 = 0; u.i2 = bb; return true; }
        u.a = acat + ((size_t)h * TB + ch * 256) * 768 * 2;
        u.b = bcat + ((size_t)(h * NCHK + ch) * 512 + nh * 256) * 768 * 2;
        u.t = nh; u.i0 = h; u.i1 = ch; u.i2 = 0; return true;
    }
};
struct EpiO {
    static constexpr bool PERM = true;
    unsigned char* ws;
    __device__ __forceinline__ void operator()(ACC_T, const Unit& u, int wr_, int wc_, int fr, int fq) const {
        int wr = wr_, wc = wc_; asm volatile("" : "+v"(wr), "+v"(wc));
        size_t z_ = 0; asm volatile("" : "+s"(z_)); unsigned char* w_ = ws + z_;
        bf16_t* O = u.i1 == 0 ? (bf16_t*)(w_ + WS_OCTX) + (size_t)u.i2 * 256 * 2048 : (bf16_t*)(w_ + WS_O) + (size_t)(u.i1 * 256) * 2048;
        const int c8 = 32 * wc + 8 * fq;
        bf16_t* op = O + u.i0 * 512 + u.t * 256 + c8;
        FOR_AI_M { const int r = 128 * ai + 64 * wr + 16 * m + fr;
            FOR_BJ { GET8(v, ai, bj, m); store8(op + (size_t)r * 2048 + 128 * bj, v); __builtin_amdgcn_sched_barrier(0); } }
    }
};

struct SchedPlain {
    int G, c, nN, K; unsigned char* ws; size_t aoff, boff; int skipctx;
    __device__ __forceinline__ bool next(int i, Unit& u) const {
        const int nM = skipctx ? 128 : 132;
        const int L = i * G + c; if (L >= nM * nN) return false;
        size_t z_ = 0; asm volatile("" : "+s"(z_)); unsigned char* w_ = ws + z_;
        const char* a = (const char*)(w_ + aoff); const char* b = (const char*)(w_ + boff);
        int pm, pn; tile_order(L, nM, nN, pm, pn);
        if (skipctx) pm = (pm >> 5) * 33 + 1 + (pm & 31);
        u.a = a + (size_t)pm * 256 * K * 2; u.b = b + (size_t)pn * 256 * K * 2; u.t = 0; u.i0 = pm; u.i1 = pn; u.i2 = 0; return true;
    }
};
struct EpiY {
    static constexpr bool PERM = true;
    unsigned char* ws;
    __device__ __forceinline__ void operator()(ACC_T, const Unit& u, int wr_, int wc_, int fr, int fq) const {
        int wr = wr_, wc = wc_; asm volatile("" : "+v"(wr), "+v"(wc));
        size_t z_ = 0; asm volatile("" : "+s"(z_)); unsigned char* w_ = ws + z_;
        bf16_t* Y = (bf16_t*)(w_ + WS_Y);
        const int c8 = 32 * wc + 8 * fq;
        bf16_t* yp = Y + (size_t)(u.i0 * 256) * 1024 + u.i1 * 256 + c8;
        FOR_AI_M { const int r = 128 * ai + 64 * wr + 16 * m + fr;
            FOR_BJ { GET8(v, ai, bj, m); store8(yp + (size_t)r * 1024 + 128 * bj, v); __builtin_amdgcn_sched_barrier(0); } }
    }
};
struct EpiLruIn {
    static constexpr bool PERM = true;
    unsigned char* ws;
    __device__ __forceinline__ void operator()(ACC_T, const Unit& u, int wr_, int wc_, int fr, int fq) const {
        int wr = wr_, wc = wc_; asm volatile("" : "+v"(wr), "+v"(wc));
        size_t z_ = 0; asm volatile("" : "+s"(z_)); unsigned char* w_ = ws + z_;
        bf16_t* XR = (bf16_t*)(w_ + WS_XR); bf16_t* GL = (bf16_t*)(w_ + WS_GZ);
        const int pm = u.i0, pn = u.i1, c8 = 32 * wc + 8 * fq;
        bf16_t* dp = (pn < 5 ? XR + pn * 256 : GL + (pn - 5) * 256) + (size_t)(pm * 256) * LW + c8;
        FOR_AI_M { const int r = 128 * ai + 64 * wr + 16 * m + fr;
            FOR_BJ { GET8(v, ai, bj, m); store8(dp + (size_t)r * LW + 128 * bj, v); __builtin_amdgcn_sched_barrier(0); } }
    }
};

struct SchedGate {
    int G, c; unsigned char* ws; int j, hf;
    __device__ __forceinline__ bool next(int i, Unit& u) const {
        const int L = i * G + c; if (L >= 1320) return false;
        size_t z_ = 0; asm volatile("" : "+s"(z_)); unsigned char* w_ = ws + z_;
        const char* xc = (const char*)(w_ + WS_XC) + (size_t)hf * 2 * TB * LW * 2; const char* wg = (const char*)(w_ + WS_WLG) + (size_t)j * 10 * 512 * 128 * 2;
        const int dir = L & 1, nb = (L >> 1) % 10, pm = L / 20;
        u.a = xc + ((size_t)pm * 256 * LW + nb * 128) * 2; u.b = wg + (size_t)(nb * 512 + dir * 256) * 128 * 2;
        u.t = dir; u.i0 = pm; u.i1 = nb; u.i2 = 0; return true;
    }
};
struct EpiGate {
    static constexpr bool PERM = false;
    unsigned char* ws; int j, hf;
    __device__ __forceinline__ void operator()(ACC_T, const Unit& u, int wr_, int wc_, int fr, int fq) const {
        int wr = wr_, wc = wc_; asm volatile("" : "+v"(wr), "+v"(wc));
        size_t z_ = 0; asm volatile("" : "+s"(z_)); unsigned char* w_ = ws + z_;
        const bf16_t* XC = (const bf16_t*)(w_ + WS_XC) + (size_t)hf * 2 * TB * LW; unsigned* AU = (unsigned*)(w_ + WS_AU);
        const float* sm_ = (const float*)(w_ + WS_SMALL); const float* ba = sm_ + SM_BA + j * 2 * LW; const float* bx = sm_ + SM_BX + j * 2 * LW; const float* c8 = (const float*)(w_ + WS_C8SP) + j * 2 * LW;
        const int dir = u.t, pm = u.i0, nb = u.i1;
        u32x2 xall[2][2][4]; f32x4 pv_[2][3];
#pragma unroll
        for (int nn = 0; nn < 2; ++nn) {
            const int ch0 = nb * 128 + 32 * wc + 16 * nn + 4 * fq;
            pv_[nn][0] = *(const f32x4*)(ba + dir * LW + ch0); pv_[nn][1] = *(const f32x4*)(bx + dir * LW + ch0); pv_[nn][2] = *(const f32x4*)(c8 + dir * LW + ch0);
            FOR_AI_M { const int lrow = pm * 256 + 128 * ai + 64 * wr + 16 * m + fr; xall[nn][ai][m] = *(const u32x2*)(XC + (size_t)lrow * LW + ch0); }
        }
        __builtin_amdgcn_sched_barrier(0);
#pragma unroll
        for (int nn = 0; nn < 2; ++nn) {
            const int ch0 = nb * 128 + 32 * wc + 16 * nn + 4 * fq;
            const f32x4 vba = pv_[nn][0], vbx = pv_[nn][1], vc8 = pv_[nn][2];
            FOR_AI_M { const int lrow = pm * 256 + 128 * ai + 64 * wr + 16 * m + fr;
                const u32x2 xw = xall[nn][ai][m];
                const float xc0 = bflo(xw.x), xc1 = bfhi(xw.x), xc2 = bflo(xw.y), xc3 = bfhi(xw.y);
                const f32x4 pa = acc[ai][0][m][nn] + vba, px = acc[ai][1][m][nn] + vbx;
                u32x4 o;
#define GATE2(PA0, PA1, PX0, PX1, C80, C81, XC0, XC1, OUT0, OUT1) { \
                    f32x2 na = (f32x2){fminf(-(PA0), 40.f), fminf(-(PA1), 40.f)} * 1.4426950408889634f, nx = (f32x2){fminf(-(PX0), 40.f), fminf(-(PX1), 40.f)} * 1.4426950408889634f; \
                    f32x2 ea = (f32x2){ex2(na.x), ex2(na.y)} + 1.f, exx = (f32x2){ex2(nx.x), ex2(nx.y)} + 1.f; const f32x2 pr = ea * exx; \
                    const f32x2 t = (f32x2){frcp(pr.x), frcp(pr.y)}; const f32x2 la = (t * exx) * (f32x2){C80, C81}, gi = t * ea; \
                    const f32x2 e1 = la * 1.4426950408889634f; const f32x2 av = (f32x2){ex2(e1.x), ex2(e1.y)}; const f32x2 om = 1.f - av * av, oma = 1.f - av; \
                    const f32x2 uu = ((f32x2){__builtin_amdgcn_sqrtf(fmaxf(om.x, 0.f)), __builtin_amdgcn_sqrtf(fmaxf(om.y, 0.f))} * gi) * (f32x2){XC0, XC1}; \
                    OUT0 = pk2(oma.x, uu.x); OUT1 = pk2(oma.y, uu.y); }
                GATE2(pa.x, pa.y, px.x, px.y, vc8.x, vc8.y, xc0, xc1, o.x, o.y) GATE2(pa.z, pa.w, px.z, px.w, vc8.z, vc8.w, xc2, xc3, o.z, o.w)
#undef GATE2
                *(u32x4*)(AU + ((size_t)lrow * 2 + dir) * LW + ch0) = o;
                __builtin_amdgcn_sched_barrier(0);
            }
        }
    }
};

__device__ __forceinline__ void transpose_item(const float* W, int N, bf16_t* WT, int ldt, LAS float* scr, int kb, int nb, int lane) {
    const int k0 = 64 * kb, n0 = 32 * nb;
    float tv[32];
#pragma unroll
    for (int i = 0; i < 32; ++i) { const int kk = 2 * i + (lane >> 5); tv[i] = W[(size_t)(k0 + kk) * N + n0 + (lane & 31)]; }
#pragma unroll
    for (int i = 0; i < 32; ++i) { const int kk = 2 * i + (lane >> 5); scr[kk * 33 + (lane & 31)] = tv[i]; }
    asm volatile("s_waitcnt lgkmcnt(0)" ::: "memory");
    const int c = lane & 7;
#pragma unroll
    for (int jj = 0; jj < 4; ++jj) { const int n = (lane >> 3) + 8 * jj; const LAS float* s = scr + (8 * c) * 33 + n;
        u32x4 o; o.x = pk2(s[0 * 33], s[1 * 33]); o.y = pk2(s[2 * 33], s[3 * 33]); o.z = pk2(s[4 * 33], s[5 * 33]); o.w = pk2(s[6 * 33], s[7 * 33]);
        *(u32x4*)(WT + (size_t)(n0 + n) * ldt + k0 + 8 * c) = o; }
    asm volatile("s_waitcnt lgkmcnt(0)" ::: "memory");
}

__device__ __forceinline__ void phase0(const Params& P, LAS unsigned char* lds) {
    const int tid = ltid(), lane = tid & 63, wave = tid >> 6, bidx = lbid(), gdim = lgdim();
    const int gw = bidx * NWAVES + wave, NGW = gdim * NWAVES;
    unsigned char* ws = P.ws;
    {
        LAS float* scr = (LAS float*)(lds + wave * 8704);
        constexpr int I_RIN = 16 * 192, I_ROUT = 32 * 32, I_LIN = 16 * 80, I_LOUT = 20 * 32, I_G = 8;
        constexpr int NIT = 2 * I_RIN + 2 * I_ROUT + 2 * I_LIN + 2 * I_LOUT + 80 * I_G;
        for (int it = gw; it < NIT; it += NGW) {
            int r = it;
            if (r < 2 * I_RIN) { const int jj = r / I_RIN; r %= I_RIN; transpose_item(P.ret_w_in + (size_t)jj * 1024 * RIN, RIN, (bf16_t*)(ws + WS_WRIN) + (size_t)jj * RIN * 1024, 1024, scr, r / 192, r % 192, lane); continue; } r -= 2 * I_RIN;
            if (r < 2 * I_ROUT) { const int jj = r / I_ROUT; r %= I_ROUT; transpose_item(P.ret_w_out + (size_t)jj * RV * 1024, 1024, (bf16_t*)(ws + WS_WROUT) + (size_t)jj * 1024 * RV, RV, scr, r / 32, r % 32, lane); continue; } r -= 2 * I_ROUT;
            if (r < 2 * I_LIN) { const int jj = r / I_LIN; r %= I_LIN; transpose_item(P.lru_w_in + (size_t)jj * 1024 * 2560, 2560, (bf16_t*)(ws + WS_WLIN) + (size_t)jj * 2560 * 1024, 1024, scr, r / 80, r % 80, lane); continue; } r -= 2 * I_LIN;
            if (r < 2 * I_LOUT) { const int jj = r / I_LOUT; r %= I_LOUT; transpose_item(P.lru_w_out + (size_t)jj * LW * 1024, 1024, (bf16_t*)(ws + WS_WLOUT) + (size_t)jj * 1024 * LW, LW, scr, r / 32, r % 32, lane); continue; } r -= 2 * I_LOUT;
            {
                const int mat = r / I_G, sub = r % I_G; const int nb = mat % 10, gate = (mat / 10) & 1, dir = (mat / 20) & 1, jj = mat / 40;
                const float* src = (gate ? P.lru_w_x : P.lru_w_a) + ((size_t)((jj * 2 + dir) * 10 + nb)) * 128 * 128;
                bf16_t* dst = (bf16_t*)(ws + WS_WLG) + ((size_t)(jj * 10 + nb) * 512 + dir * 256 + gate * 128) * 128;
                transpose_item(src, 128, dst, 128, scr, sub / 4, sub % 4, lane);
            }
        }
    }
    {
        const int gt = bidx * NTHR + tid, NGT = gdim * NTHR;
        f32x2* rope = (f32x2*)(ws + WS_ROPE); f32x2* ropeT = (f32x2*)(ws + WS_ROPET); float* c8 = (float*)(ws + WS_C8SP);
        for (int i = gt; i < 128 * 64; i += NGT) { const int p = i >> 6, f = i & 63;
            const float inv = powf(10000.f, -(float)f / 64.f); const float ang = (float)p * inv; float sn, cs; sincosf(ang, &sn, &cs);
            rope[p * 64 + f] = (f32x2){cs, sn}; ropeT[f * 128 + p] = (f32x2){cs, sn}; }
        for (int i = gt; i < 2 * 2 * LW; i += NGT) { const float lam = P.lru_lambda[i]; c8[i] = -8.f * log1pf(expf(-lam)); }
        float* sm = (float*)(ws + WS_SMALL);
        for (int i = gt; i < SM_END; i += NGT) {
            float v;
            if (i < SM_NPOST) v = P.norm_pre[i];
            else if (i < SM_GN) v = P.norm_post[i - SM_NPOST];
            else if (i < SM_L2D) v = P.ret_gn[i - SM_GN];
            else if (i < SM_CW) v = -fabsf(P.ret_log_decay[i - SM_L2D]) * 1.4426950408889634f;
            else if (i < SM_CB) v = P.lru_conv_w[i - SM_CW];
            else if (i < SM_BA) v = P.lru_conv_b[i - SM_CB];
            else if (i < SM_BX) v = P.lru_b_a[i - SM_BA];
            else v = P.lru_b_x[i - SM_BX];
            sm[i] = v;
        }
    }
    __syncthreads();
    {
        LAS float* act = (LAS float*)lds;
        LAS float* red = (LAS float*)(lds + 5 * 1024 * 4);
        float* modv = (float*)(ws + WS_MOD);
        bool have_act = false;
        for (int task = bidx; task < 4 * 48; task += gdim) {
            const int layer = task / 48, nt = task % 48;
            if (!have_act) {
                __syncthreads();
                for (int i = tid; i < 5 * 1024; i += NTHR) { const float cv = i < 4096 ? P.c[i] : P.c_ctx[i - 4096]; act[i] = cv / (1.f + expf(-cv)); }
                __syncthreads(); have_act = true;
            }
            const int n = tid & 63, ks = tid >> 6;
            const float* wp = P.mod_w + ((size_t)layer * 1024 + ks * 128) * 3072 + nt * 64 + n;
            float a0 = 0.f, a1 = 0.f, a2 = 0.f, a3 = 0.f, a4 = 0.f;
#pragma unroll 32
            for (int k = 0; k < 128; ++k) { const float w = wp[(size_t)k * 3072]; const int kk = ks * 128 + k;
                a0 += act[kk] * w; a1 += act[1024 + kk] * w; a2 += act[2048 + kk] * w; a3 += act[3072 + kk] * w; a4 += act[4096 + kk] * w; }
            red[(ks * 5 + 0) * 64 + n] = a0; red[(ks * 5 + 1) * 64 + n] = a1; red[(ks * 5 + 2) * 64 + n] = a2; red[(ks * 5 + 3) * 64 + n] = a3; red[(ks * 5 + 4) * 64 + n] = a4;
            __syncthreads();
            if (tid < 320) { const int s = tid >> 6, nn = tid & 63; float sum = 0.f;
#pragma unroll
                for (int q = 0; q < 8; ++q) sum += red[(q * 5 + s) * 64 + nn];
                const int col = nt * 64 + nn; modv[(size_t)(layer * 5 + s) * 3072 + col] = sum + P.mod_b[layer * 3072 + col]; }
            __syncthreads();
        }
    }
    __syncthreads();
}

__device__ __forceinline__ void post_phase(const float* xin, const float* ctxin, float* outp, unsigned char* ws, int layer, LAS unsigned char* lds) {
    const int tid = ltid(), lane = tid & 63, wave = tid >> 6;
    const int gw = lbid() * NWAVES + wave, NGW = lgdim() * NWAVES;
    const float* sm = (const float*)(ws + WS_SMALL);
    const float* modv = (const float*)(ws + WS_MOD);
    const bf16_t* Y = (const bf16_t*)(ws + WS_Y);
    float* xctx = (float*)(ws + WS_XCTX);
    bf16_t* Hn = (bf16_t*)(ws + WS_HN);
    const int nl = layer + 1;
    LAS float* pl = (LAS float*)lds;
    for (int i = tid; i < 5 * 1024; i += NTHR) { const int s = i >> 10, col = i & 1023;
        if (layer >= 0) pl[i] = modv[(size_t)(layer * 5 + s) * 3072 + 2048 + col];
        if (nl < 4) { pl[5120 + i] = modv[(size_t)(nl * 5 + s) * 3072 + col]; pl[10240 + i] = modv[(size_t)(nl * 5 + s) * 3072 + 1024 + col]; } }
    for (int i = tid; i < 1024; i += NTHR) { if (layer >= 0) pl[15360 + i] = sm[SM_NPOST + layer * DM + i]; if (nl < 4) pl[16384 + i] = sm[SM_NPRE + nl * DM + i]; }
    __syncthreads();
#define POST_LOAD(XV, YW, R0) do { _Pragma("unroll") for (int u = 0; u < 2; ++u) { \
            const int row_ = (R0) + u * NGW; const int rowc_ = row_ < MROWS ? row_ : (R0); \
            const int b_ = rowc_ / TB, pos_ = rowc_ - b_ * TB; const bool isctx_ = pos_ < CTXL; \
            const size_t xoff_ = isctx_ ? ((size_t)(b_ * CTXL + pos_) * DM) : ((size_t)(b_ * SEQ + pos_ - CTXL) * DM); \
            const float* xs_ = (layer <= 0) ? (isctx_ ? ctxin + xoff_ : xin + xoff_) : (isctx_ ? xctx + xoff_ : outp + xoff_); \
            _Pragma("unroll") for (int q = 0; q < 4; ++q) XV[u][q] = *(const f32x4*)(xs_ + 4 * lane + 256 * q); \
            if (layer >= 0) { _Pragma("unroll") for (int q = 0; q < 4; ++q) YW[u][q] = *(const u32x2*)(Y + (size_t)rowc_ * DM + 4 * lane + 256 * q); } } } while (0)
    f32x4 xv[2][4]; u32x2 yw[2][4];
    if (gw < MROWS) POST_LOAD(xv, yw, gw);
    for (int row0 = gw; row0 < MROWS; row0 += 2 * NGW) {
        f32x4 xn[2][4]; u32x2 yn[2][4];
        const int nrow0 = row0 + 2 * NGW;
        if (nrow0 < MROWS) POST_LOAD(xn, yn, nrow0);
#pragma unroll
        for (int u = 0; u < 2; ++u) {
            const int row = row0 + u * NGW; const bool valid = row < MROWS; const int rowc = valid ? row : row0;
            const int b = rowc / TB, pos = rowc - b * TB; const bool isctx = pos < CTXL; const int s = isctx ? 4 : b;
            if (!(valid && !(layer == 3 && isctx))) continue;
            const size_t xoff = isctx ? ((size_t)(b * CTXL + pos) * DM) : ((size_t)(b * SEQ + pos - CTXL) * DM);
            float* xd = isctx ? xctx + xoff : outp + xoff;
            if (layer >= 0) {
                f32x4 yv[4]; float ss = 0.f;
#pragma unroll
                for (int q = 0; q < 4; ++q) { yv[q] = (f32x4){bflo(yw[u][q].x), bfhi(yw[u][q].x), bflo(yw[u][q].y), bfhi(yw[u][q].y)}; ss += (yv[q].x * yv[q].x + yv[q].y * yv[q].y) + (yv[q].z * yv[q].z + yv[q].w * yv[q].w); }
                const float rs = __builtin_amdgcn_rsqf(wave_sum(ss) * (1.f / DM) + EPS);
#pragma unroll
                for (int q = 0; q < 4; ++q) { const f32x4 g = *(const LAS f32x4*)(pl + s * 1024 + 4 * lane + 256 * q), w = *(const LAS f32x4*)(pl + 15360 + 4 * lane + 256 * q);
                    xv[u][q] = xv[u][q] + g * (yv[q] * rs * w); *(f32x4*)(xd + 4 * lane + 256 * q) = xv[u][q]; }
            }
            if (nl < 4) {
                float ss = 0.f;
#pragma unroll
                for (int q = 0; q < 4; ++q) ss += (xv[u][q].x * xv[u][q].x + xv[u][q].y * xv[u][q].y) + (xv[u][q].z * xv[u][q].z + xv[u][q].w * xv[u][q].w);
                const float rs = __builtin_amdgcn_rsqf(wave_sum(ss) * (1.f / DM) + EPS);
#pragma unroll
                for (int q = 0; q < 4; ++q) { const f32x4 a = *(const LAS f32x4*)(pl + 5120 + s * 1024 + 4 * lane + 256 * q), c = *(const LAS f32x4*)(pl + 10240 + s * 1024 + 4 * lane + 256 * q), w = *(const LAS f32x4*)(pl + 16384 + 4 * lane + 256 * q);
                    const f32x4 hv = (xv[u][q] * rs * w) * (c + 1.f) + a;
                    u32x2 o; o.x = pk2(hv.x, hv.y); o.y = pk2(hv.z, hv.w);
                    *(u32x2*)(Hn + (size_t)row * DM + 4 * lane + 256 * q) = o; }
            }
        }
#pragma unroll
        for (int u = 0; u < 2; ++u)
#pragma unroll
            for (int q = 0; q < 4; ++q) { xv[u][q] = xn[u][q]; yw[u][q] = yn[u][q]; }
    }
#undef POST_LOAD
    __syncthreads();
}

__device__ __forceinline__ void ret_scan(unsigned char* ws, int j) {
    bf16_t* Bcat = (bf16_t*)(ws + WS_BCAT); const float* l2d = (const float*)(ws + WS_SMALL) + SM_L2D;
    const int bid_ = lbid(), ng_ = lgdim(), tid_ = ltid();
    int gt0, NGT, ilim = 4 * 512 * 128;
    if (ng_ > 132 + 32) {
        if (bid_ < 132) { if (tid_ >= 256) return; gt0 = bid_ * 256 + tid_; NGT = 1 << 30; ilim = 132 * 256; }
        else { gt0 = 132 * 256 + (bid_ - 132) * NTHR + tid_; NGT = (ng_ - 132) * NTHR; }
    } else { gt0 = bid_ * NTHR + tid_; NGT = ng_ * NTHR; }
    for (int idx = gt0; idx < ilim; idx += NGT) {
        const int u_ = __builtin_amdgcn_readfirstlane(idx >> 6); const int dg = idx & 63, dir = u_ & 1, e = (u_ >> 1) & 511, h = u_ >> 10;
        const float dec = ex2(lg2dec(l2d, j, dir, h) * 256.f);
        bf16_t* base = Bcat + ((size_t)(h * NCHK) * 512 + e) * 768 + 256 + dir * 256 + dg * 4;
        float run[4] = {0.f, 0.f, 0.f, 0.f};
        u32x2 loc[33];
#pragma unroll
        for (int k = 0; k < 33; ++k) { const int ch = dir == 0 ? k : (k == 0 ? 0 : 33 - k); loc[k] = *(const u32x2*)(base + (size_t)ch * 512 * 768); }
#pragma unroll
        for (int k = 0; k < 33; ++k) { const int ch = dir == 0 ? k : (k == 0 ? 0 : 33 - k);
            u32x2 o; o.x = pk2(run[0], run[1]); o.y = pk2(run[2], run[3]);
            *(u32x2*)(base + (size_t)ch * 512 * 768) = o;
            run[0] = run[0] * dec + bflo(loc[k].x); run[1] = run[1] * dec + bfhi(loc[k].x); run[2] = run[2] * dec + bflo(loc[k].y); run[3] = run[3] * dec + bfhi(loc[k].y); }
    }
}

__device__ __forceinline__ void ret_gn(unsigned char* ws, int j, int b, bool weighted, bool ctxrows) {
    const int tid = ltid(), lane = tid & 63, wave = tid >> 6;
    const int gw = lbid() * NWAVES + wave, NGW = lgdim() * NWAVES;
    const bf16_t* O = ctxrows ? (const bf16_t*)(ws + WS_OCTX) : (const bf16_t*)(ws + WS_O) + (size_t)CTXL * 2048;
    bf16_t* G = (bf16_t*)(ws + WS_GZ) + (ctxrows ? (size_t)0 : ((size_t)b * TB + CTXL) * 2048);
    const int npos = ctxrows ? NB * CTXL : SEQ;
    const float* gn = (const float*)(ws + WS_SMALL) + SM_GN + j * RV;
    const int bid_ = gw / NWAVES, ng_ = NGW / NWAVES; const bool wgt = weighted && ng_ == 256;
    const int slot0 = wgt ? (bid_ < 24 ? 0 : (bid_ - 24)) : bid_, nslot = wgt ? (bid_ < 24 ? 0 : 1) : 1, tslots = wgt ? 232 : ng_;
    for (int sl = slot0; sl < slot0 + nslot; ++sl)
    for (int pos = sl * NWAVES + wave; pos < npos; pos += tslots * NWAVES) {
        const size_t grow = ctxrows ? (size_t)(pos >> 8) * TB + (pos & 255) : (size_t)pos;
        u32x4 ow[4], gwv[4];
#pragma unroll
        for (int h = 0; h < 4; ++h) { const size_t off = (size_t)pos * 2048 + h * 512 + lane * 8, goff = grow * 2048 + h * 512 + lane * 8; ow[h] = *(const u32x4*)(O + off); gwv[h] = *(const u32x4*)(G + goff); }
#pragma unroll
        for (int h = 0; h < 4; ++h) {
            const size_t off = grow * 2048 + h * 512 + lane * 8;
            const f32x4 w0 = *(const f32x4*)(gn + h * 512 + lane * 8), w1 = *(const f32x4*)(gn + h * 512 + lane * 8 + 4);
            float ov[8], gv[8]; unpack8(ow[h], ov); unpack8(gwv[h], gv);
            float sacc = 0.f;
#pragma unroll
            for (int q = 0; q < 8; ++q) sacc += ov[q];
            const float mu = wave_sum(sacc) * (1.f / 512.f); float s2 = 0.f;
#pragma unroll
            for (int q = 0; q < 8; ++q) { ov[q] -= mu; s2 += ov[q] * ov[q]; }
            const float rstd = __builtin_amdgcn_rsqf(wave_sum(s2) * (1.f / 512.f) + EPS);
            const float wv[8] = {w0.x, w0.y, w0.z, w0.w, w1.x, w1.y, w1.z, w1.w};
            float z[8];
#pragma unroll
            for (int q = 0; q < 8; ++q) z[q] = ov[q] * rstd * wv[q] * (gv[q] * sigm(gv[q]));
            store8(G + off, z);
        }
    }
}

__device__ __forceinline__ void lru_conv(unsigned char* ws, int j) {
    const bf16_t* XR = (const bf16_t*)(ws + WS_XR); bf16_t* XC = (bf16_t*)(ws + WS_XC);
    const float* cw = (const float*)(ws + WS_SMALL) + SM_CW + (size_t)j * 4 * LW; const float* cb = (const float*)(ws + WS_SMALL) + SM_CB + j * LW;
    const int NGT = lgdim() * NTHR; const int gt0 = lbid() * NTHR + ltid();
    for (int idx = gt0; idx < (MROWS / 8) * 160; idx += NGT) {
        const int cgp = idx % 160, rb = idx / 160, row0 = rb * 8, ch0 = cgp * 8;
        const int b = row0 / TB, pos0 = row0 - b * TB; const int s0 = pos0 < CTXL ? 0 : CTXL, e0 = pos0 < CTXL ? CTXL : TB;
        float w[4][8], bias[8];
#pragma unroll
        for (int t = 0; t < 4; ++t) { const f32x4 a = *(const f32x4*)(cw + t * LW + ch0), c = *(const f32x4*)(cw + t * LW + ch0 + 4);
            w[t][0] = a.x; w[t][1] = a.y; w[t][2] = a.z; w[t][3] = a.w; w[t][4] = c.x; w[t][5] = c.y; w[t][6] = c.z; w[t][7] = c.w; }
        { const f32x4 a = *(const f32x4*)(cb + ch0), c = *(const f32x4*)(cb + ch0 + 4); bias[0] = a.x; bias[1] = a.y; bias[2] = a.z; bias[3] = a.w; bias[4] = c.x; bias[5] = c.y; bias[6] = c.z; bias[7] = c.w; }
        u32x4 xin[11];
#pragma unroll
        for (int k = 0; k < 11; ++k) { const int pp = pos0 - 2 + k; const bool ok = pp >= s0 && pp < e0;
            xin[k] = ok ? *(const u32x4*)(XR + (size_t)(row0 - 2 + k) * LW + ch0) : (u32x4){0u, 0u, 0u, 0u}; }
#pragma unroll
        for (int r = 0; r < 8; ++r) {
            float o[8], t0[8], t1[8], t2[8], t3[8];
            unpack8(xin[r], t0); unpack8(xin[r + 1], t1); unpack8(xin[r + 2], t2); unpack8(xin[r + 3], t3);
#pragma unroll
            for (int q = 0; q < 8; ++q) o[q] = bias[q] + t0[q] * w[0][q] + t1[q] * w[1][q] + t2[q] * w[2][q] + t3[q] * w[3][q];
            store8(XC + (size_t)(row0 + r) * LW + ch0, o);
        }
    }
}

__device__ __forceinline__ void lru_p1(unsigned char* ws) {
    const unsigned* AU = (const unsigned*)(ws + WS_AU); f32x2* agg = (f32x2*)(ws + WS_AGG);
    const int NGT = lgdim() * NTHR; const int gt0 = lbid() * NTHR + ltid();
    for (int idx = gt0; idx < 2 * NSEG * LW; idx += NGT) {
        const int q_ = __builtin_amdgcn_readfirstlane(idx / LW), ch = idx - q_ * LW, sg = q_ % NSEG, bl = q_ / NSEG;
        const unsigned* p = AU + ((size_t)(bl * TB + sg * 32) * 2) * LW + ch;
        unsigned w0[32], w1[32];
#pragma unroll
        for (int t = 0; t < 32; ++t) { w0[t] = p[(size_t)(2 * t) * LW]; w1[t] = p[(size_t)(2 * t + 1) * LW]; }
        float sl = 1.f, hh = 0.f;
#pragma unroll
        for (int t = 0; t < 32; ++t) { const float a = 1.f - bflo(w0[t]); sl *= a; hh = a * hh + bfhi(w0[t]); }
        agg[((size_t)(bl * 2 + 0) * NSEG + sg) * LW + ch] = (f32x2){sl, hh};
        sl = 1.f; hh = 0.f;
#pragma unroll
        for (int t = 31; t >= 0; --t) { const float a = 1.f - bflo(w1[t]); sl *= a; hh = a * hh + bfhi(w1[t]); }
        agg[((size_t)(bl * 2 + 1) * NSEG + sg) * LW + ch] = (f32x2){sl, hh};
    }
}
__device__ __forceinline__ void lru_p2(unsigned char* ws, LAS unsigned char* lds) {
    const f32x2* agg = (const f32x2*)(ws + WS_AGG); float* carry = (float*)(ws + WS_CARRY);
    LAS f32x2* gl = (LAS f32x2*)lds;
    const int tid = ltid(), bid = lbid(), ng = lgdim();
    const int g = tid >> 6, cl = tid & 63;
    for (int task = bid; task < 4 * 20; task += ng) {
        const int bd = task / 20, ch = (task % 20) * 64 + cl, dir = bd & 1;
        const f32x2* ap = agg + (size_t)bd * NSEG * LW + ch; float* cp = carry + (size_t)bd * NSEG * LW + ch;
        f32x2 av[33];
#pragma unroll
        for (int k = 0; k < 33; ++k) { const int s = g * 33 + k, sg = dir == 0 ? s : (s < 8 ? 7 - s : 271 - s); av[k] = ap[(size_t)sg * LW]; }
        float A = 1.f, H = 0.f;
#pragma unroll
        for (int k = 0; k < 33; ++k) { H = av[k].x * H + av[k].y; A *= av[k].x; }
        __syncthreads();
        gl[g * 64 + cl] = (f32x2){A, H};
        __syncthreads();
        float run = 0.f;
        for (int gg = 0; gg < g; ++gg) { const f32x2 t = gl[gg * 64 + cl]; run = t.x * run + t.y; }
#pragma unroll
        for (int k = 0; k < 33; ++k) { const int s = g * 33 + k, sg = dir == 0 ? s : (s < 8 ? 7 - s : 271 - s); cp[(size_t)sg * LW] = run; run = av[k].x * run + av[k].y; }
    }
    __syncthreads();
}
__device__ __forceinline__ void lru_p3(unsigned char* ws, int hf) {
    const unsigned* AU = (const unsigned*)(ws + WS_AU); const float* carry = (const float*)(ws + WS_CARRY);
    bf16_t* GL = (bf16_t*)(ws + WS_GZ) + (size_t)hf * 2 * TB * LW;
    const int NGT = lgdim() * NTHR; const int gt0 = lbid() * NTHR + ltid();
    for (int idx = gt0; idx < 2 * NSEG * LW; idx += NGT) {
        const int q_ = __builtin_amdgcn_readfirstlane(idx / LW), ch = idx - q_ * LW, sg = q_ % NSEG, bl = q_ / NSEG;
        const size_t lrow0 = (size_t)bl * TB + sg * 32;
        const unsigned* p = AU + (lrow0 * 2) * LW + ch;
        unsigned w0[32], w1[32];
#pragma unroll
        for (int t = 0; t < 32; ++t) { w0[t] = p[(size_t)(2 * t) * LW]; w1[t] = p[(size_t)(2 * t + 1) * LW]; }
        float hcur = carry[((size_t)(bl * 2 + 0) * NSEG + sg) * LW + ch];
        float hb = carry[((size_t)(bl * 2 + 1) * NSEG + sg) * LW + ch];
        bf16_t* gp = GL + lrow0 * LW + ch;
        bf16_t gvv[32];
#pragma unroll
        for (int t = 0; t < 32; ++t) gvv[t] = gp[(size_t)t * LW];
        float hfv[32];
#pragma unroll
        for (int t = 0; t < 32; ++t) { hcur = (1.f - bflo(w0[t])) * hcur + bfhi(w0[t]); hfv[t] = hcur; }
#pragma unroll
        for (int t = 31; t >= 0; --t) { hb = (1.f - bflo(w1[t])) * hb + bfhi(w1[t]);
            const float g = bf1(gvv[t]); const float z = (hfv[t] + hb) * (g * sigm(g));
            gp[(size_t)t * LW] = (bf16_t)(pk2(z, 0.f) & 0xffffu); }
    }
}

#define XB_TMO      128
#define XB_XCNT(j)  (256  + 64 * (j))
#define XB_XSUB(j)  (1280 + 64 * (j))
#define XB_XGEN(j)  (2304 + 64 * (j))
#define XB_TOP      3328
#define XB_TOPGEN   3392
#define XCD_BAR_WORDS 3456
#define XB_SPIN_CAP (1u << 18)
__device__ __forceinline__ unsigned xb_ld(unsigned* p)              { return __hip_atomic_load(p, __ATOMIC_RELAXED, __HIP_MEMORY_SCOPE_AGENT); }
__device__ __forceinline__ unsigned xb_add(unsigned* p, unsigned v) { return __hip_atomic_fetch_add(p, v, __ATOMIC_RELAXED, __HIP_MEMORY_SCOPE_AGENT); }
__device__ __forceinline__ unsigned xb_xcc_id() { return (unsigned)__builtin_amdgcn_s_getreg((3 << 11) | 20) & 0xFu; }
#define XB_SPIN(cond, bar) do { unsigned _sp = 0; while (cond) { __builtin_amdgcn_s_sleep(1); \
    if ((++_sp & 255u) == 0u) { if (xb_ld(&(bar)[XB_TMO])) break; if (_sp > XB_SPIN_CAP) { atomicAdd(&(bar)[XB_TMO], 1u); break; } } } } while (0)
struct XcdBarrier { unsigned* bar; unsigned x; volatile LAS unsigned* st; };
__device__ __forceinline__ XcdBarrier xcd_barrier_post(unsigned* bar, volatile LAS unsigned* st) {
    XcdBarrier b; b.bar = bar; b.x = xb_xcc_id(); b.st = st;
    if (threadIdx.x == 0) (void)xb_add(&bar[XB_XCNT(b.x)], 1u);
    return b;
}
__device__ __forceinline__ void xcd_barrier_complete(unsigned* bar, unsigned x, unsigned& nloc, unsigned& nx) {
    const unsigned G = gridDim.x * gridDim.y * gridDim.z;
    unsigned sum, cnt, mine, sp = 0u;
    for (;;) {
        sum = 0u; cnt = 0u; mine = 0u;
#pragma unroll
        for (unsigned j = 0; j < 16; ++j) { const unsigned c = xb_ld(&bar[XB_XCNT(j)]); sum += c; cnt += (c > 0u) ? 1u : 0u; mine = (j == x) ? c : mine; }
        if (sum == G) break;
        __builtin_amdgcn_s_sleep(1);
        if ((++sp & 255u) == 0u) { if (xb_ld(&bar[XB_TMO])) break; if (sp > XB_SPIN_CAP) { atomicAdd(&bar[XB_TMO], 1u); break; } }
    }
    nloc = mine > 0u ? mine : 1u; nx = cnt > 0u ? cnt : 1u;
}
__device__ __forceinline__ void xcd_barrier(const XcdBarrier& b) {
    asm volatile("s_waitcnt vmcnt(0)" ::: "memory");
    __syncthreads();
    if (threadIdx.x == 0) {
        unsigned* bar = b.bar;
        __builtin_amdgcn_s_waitcnt(0);
        unsigned nloc = b.st[0], nx = b.st[1];
        if (nloc == 0u) { xcd_barrier_complete(bar, b.x, nloc, nx); b.st[0] = nloc; b.st[1] = nx; }
        const unsigned old = xb_add(&bar[XB_XSUB(b.x)], 1u);
        const unsigned gen = old / nloc;
        if (old + 1u == (gen + 1u) * nloc) {
            __builtin_amdgcn_fence(__ATOMIC_RELEASE, "agent");
            asm volatile("s_waitcnt vmcnt(0)" ::: "memory");
            const unsigned og = xb_add(&bar[XB_TOP], 1u);
            const unsigned tg = og / nx;
            if (og + 1u == (tg + 1u) * nx) xb_add(&bar[XB_TOPGEN], 1u);
            else XB_SPIN(xb_ld(&bar[XB_TOPGEN]) == tg, bar);
            __builtin_amdgcn_fence(__ATOMIC_ACQUIRE, "agent");
            xb_add(&bar[XB_XGEN(b.x)], 1u);
            asm volatile("s_waitcnt vmcnt(0)" ::: "memory");
        } else {
            XB_SPIN(xb_ld(&bar[XB_XGEN(b.x)]) == gen, bar);
            __builtin_amdgcn_fence(__ATOMIC_ACQUIRE, "agent");
            asm volatile("s_waitcnt vmcnt(0)" ::: "memory");
        }
    }
    __syncthreads();
}

#ifndef PROBE_SYNC
#define PROBE_SYNC 0
#endif
#ifndef GEMM_REP
#define GEMM_REP 1
#endif
#ifndef ELT_REP
#define ELT_REP 1
#endif
#ifndef REP_A
#define REP_A 1
#endif
#ifndef REP_B
#define REP_B 1
#endif
#ifndef REP_C
#define REP_C 1
#endif
#define REPA _Pragma("unroll 1") for (int rep_ = 0; rep_ < GEMM_REP * REP_A; ++rep_)
#define REPB _Pragma("unroll 1") for (int rep_ = 0; rep_ < GEMM_REP * REP_B; ++rep_)
#define REPC _Pragma("unroll 1") for (int rep_ = 0; rep_ < GEMM_REP * REP_C; ++rep_)
#define REPG _Pragma("unroll 1") for (int rep_ = 0; rep_ < GEMM_REP; ++rep_)
#define REPE _Pragma("unroll 1") for (int rep_ = 0; rep_ < ELT_REP; ++rep_)
__global__ __launch_bounds__(512, 2) void fwd_megakernel(Params P) {
    extern __shared__ __attribute__((aligned(16))) unsigned char shm[];
    LAS unsigned char* lds = (LAS unsigned char*)shm;
    cg::grid_group grid = cg::this_grid();
    if (threadIdx.x == 0) { *(volatile LAS unsigned*)(lds + 131072) = 0u; *(volatile LAS unsigned*)(lds + 131076) = 0u; }
    __syncthreads();
    (void)xcd_barrier_post((unsigned*)(P.ws + WS_BAR), (volatile LAS unsigned*)(lds + 131072));
#define SYNC() do { XcdBarrier xb_; xb_.bar = (unsigned*)(P.ws + WS_BAR); xb_.x = xb_xcc_id(); xb_.st = (volatile LAS unsigned*)(lds + 131072); xcd_barrier(xb_); if (PROBE_SYNC) xcd_barrier(xb_); } while (0)
#define WSL() size_t zz_ = 0; asm volatile("" : "+s"(zz_)); unsigned char* ws = P.ws + zz_; const int G = lgdim(), c = lbid(); (void)G; (void)c

    phase0(P, lds);
    if (gridDim.x > 65536u) grid.sync();
    SYNC();
    { WSL(); post_phase(P.x, P.ctx, P.out, ws, -1, lds); }
    SYNC();
#pragma unroll 1
    for (int layer = 0; layer < 4; ++layer) {
        const int j = layer >> 1;
        if ((layer & 1) == 0) {
#pragma unroll 1
            for (int b = 0; b < NB; ++b) {
                {
                    WSL();
                    SchedRetIn S{G, c, ws, j, b};
                    EpiRetIn E{ws, j, b};
                    REPA gemm_phase(lds, 1024, 1024, 1024, S, E);
                    if (b > 0) ret_gn(ws, j, b - 1, true, false);
                }
                SYNC();
                {
                    WSL();
                    SchedLoc S2{G, c, ws};
                    EpiLoc E2{ws};
                    REPB gemm_phase(lds, 256, 768, 256, S2, E2);
                }
                SYNC();
                {
                    WSL();
                    SchedS S{G, c, ws};
                    EpiS E{ws, j, b};
                    REPB gemm_phase(lds, 256, 768, 1024, S, E);
                    ret_scan(ws, j);
                }
                SYNC();
                {
                    WSL();
                    SchedO S{G, c, ws, 0};
                    EpiO E{ws};
                    REPB gemm_phase(lds, 768, 768, 768, S, E);
                    if (b == NB - 1) {
                        SchedO Sc{G, (c + 32) % G, ws, 1};
                        REPB gemm_phase(lds, 256, 256, 256, Sc, E);
                    }
                }
                SYNC();
            }
            { WSL(); ret_gn(ws, j, NB - 1, false, false); ret_gn(ws, j, 0, false, true); }
            SYNC();
            {
                WSL();
                SchedPlain S{G, c, 4, RV, ws, WS_GZ, WS_WROUT + (size_t)j * 1024 * RV * 2, 0};
                EpiY E{ws};
                REPG gemm_phase(lds, RV, RV, RV, S, E);
            }
            SYNC();
        } else {
            {
                WSL();
                SchedPlain S{G, c, 10, 1024, ws, WS_HN, WS_WLIN + (size_t)j * 2560 * 1024 * 2, 0};
                EpiLruIn E{ws};
                REPG gemm_phase(lds, 1024, 1024, 1024, S, E);
            }
            SYNC();
            { WSL(); REPE lru_conv(ws, j); }
            SYNC();
#pragma unroll 1
            for (int hf = 0; hf < 2; ++hf) {
                {
                    WSL();
                    SchedGate S{G, c, ws, j, hf};
                    EpiGate E{ws, j, hf};
                    REPC gemm_phase(lds, 128, LW, 128, S, E);
                }
                SYNC();
                { WSL(); REPE lru_p1(ws); }
                SYNC();
                { WSL(); REPE lru_p2(ws, lds); }
                SYNC();
                { WSL(); lru_p3(ws, hf); }
                SYNC();
            }
            {
                WSL();
                SchedPlain S{G, c, 4, LW, ws, WS_GZ, WS_WLOUT + (size_t)j * 1024 * LW * 2, layer == 3 ? 1 : 0};
                EpiY E{ws};
                REPG gemm_phase(lds, LW, LW, LW, S, E);
            }
            SYNC();
        }
        { WSL(); post_phase(P.x, P.ctx, P.out, ws, layer, lds); }
        if (layer < 3) SYNC();
    }
}

extern "C" void kernel_launch(void* const* d_in, const int* in_sizes, int n_in, void* d_out, int out_size, void* d_ws, size_t ws_size, hipStream_t stream) {
    static int grid_blocks = 0;
    if (grid_blocks == 0) {
        if (n_in != 21 || out_size != NB * SEQ * DM || ws_size < WS_END) { fprintf(stderr, "kernel_launch: unexpected shapes (n_in %d, out %d, ws %zu < %zu)\n", n_in, out_size, ws_size, (size_t)WS_END); grid_blocks = -1; return; }
        int dev = 0, cus = 0, per_cu = 0;
        hipGetDevice(&dev);
        hipDeviceGetAttribute(&cus, hipDeviceAttributeMultiprocessorCount, dev);
        if (hipFuncSetAttribute((const void*)fwd_megakernel, hipFuncAttributeMaxDynamicSharedMemorySize, LDS_BYTES) != hipSuccess) { fprintf(stderr, "kernel_launch: hipFuncSetAttribute failed\n"); }
        if (hipOccupancyMaxActiveBlocksPerMultiprocessor(&per_cu, (const void*)fwd_megakernel, NTHR, LDS_BYTES) != hipSuccess || per_cu < 1) per_cu = 1;
        (void)hipGetLastError();
        grid_blocks = cus * 1;
        if (grid_blocks <= 0) grid_blocks = 256;
    }
    if (grid_blocks < 0) return;
    Params p{};
    p.x = (const float*)d_in[0]; p.c = (const float*)d_in[1]; p.ctx = (const float*)d_in[2]; p.c_ctx = (const float*)d_in[3];
    p.mod_w = (const float*)d_in[4]; p.mod_b = (const float*)d_in[5]; p.norm_pre = (const float*)d_in[6]; p.norm_post = (const float*)d_in[7];
    p.ret_w_in = (const float*)d_in[8]; p.ret_log_decay = (const float*)d_in[9]; p.ret_gn = (const float*)d_in[10]; p.ret_w_out = (const float*)d_in[11];
    p.lru_w_in = (const float*)d_in[12]; p.lru_conv_w = (const float*)d_in[13]; p.lru_conv_b = (const float*)d_in[14];
    p.lru_w_a = (const float*)d_in[15]; p.lru_b_a = (const float*)d_in[16]; p.lru_w_x = (const float*)d_in[17]; p.lru_b_x = (const float*)d_in[18];
    p.lru_lambda = (const float*)d_in[19]; p.lru_w_out = (const float*)d_in[20];
    p.out = (float*)d_out; p.ws = (unsigned char*)d_ws;
    if (hipMemsetAsync((char*)d_ws + WS_BAR, 0, WS_BAR_BYTES, stream) != hipSuccess) fprintf(stderr, "kernel_launch: memset of barrier words failed\n");
    void* args[] = {&p};
    hipError_t e = hipLaunchCooperativeKernel((const void*)fwd_megakernel, dim3(grid_blocks), dim3(NTHR), args, LDS_BYTES, stream);
    if (e != hipSuccess) fprintf(stderr, "cooperative launch failed: %s (grid %d)\n", hipGetErrorString(e), grid_blocks);
}
```
